# Optimizing an MI355X kernel written in HIP

```python
import math
import jax, jax.numpy as jnp
from jax import lax
import numpy as np

D_MODEL = 1024
BATCH = 8
SEQ = 2048
DEPTH = 4

N_BRANCH = 4
MIX_WIDTH = D_MODEL // N_BRANCH
CONV_WIDTH = 3
SSM_GROUP = 16
SSM_GROUPS = MIX_WIDTH // SSM_GROUP
SSM_STATE = 64
DT_MIN = 1e-3
DT_MAX = 1e-1
LAMBDA_RE_MAX = -1e-4
POOL_WINDOWS = (2, 4, 8, 16)
POOL_GROUP = MIX_WIDTH // len(POOL_WINDOWS)
SB_HEAD_DIM = 64
SB_HEADS = MIX_WIDTH // SB_HEAD_DIM
Q_BLOCK = 128
D_FF = 2816
FFN_RES_WEIGHT = 0.5
N_SUB = 3
EPS = 1e-6

CONV_COLS = 3 * MIX_WIDTH
SSM_COLS = MIX_WIDTH
POOL_COLS = MIX_WIDTH
SB_COLS = 3 * MIX_WIDTH
GATE_COLS = N_BRANCH * D_MODEL
IN_COLS = CONV_COLS + SSM_COLS + POOL_COLS + SB_COLS + GATE_COLS
IN_SPLITS = (CONV_COLS, CONV_COLS + SSM_COLS, CONV_COLS + SSM_COLS + POOL_COLS,
             CONV_COLS + SSM_COLS + POOL_COLS + SB_COLS)

kernel_name = "hybrid_parallel_gated_mixer_trunk"


def rmsnorm(x, g):
    xf = x.astype(jnp.float32)
    y = xf * lax.rsqrt(jnp.mean(xf * xf, axis=-1, keepdims=True) + EPS)
    return (y * g.astype(jnp.float32)).astype(x.dtype)


def modulate(h, shift, scale):
    return h * (1.0 + scale[:, None, :]) + shift[:, None, :]


def swiglu_ffn(h, w_in, w_out):
    a, b = jnp.split(h @ w_in, 2, axis=-1)
    return (jax.nn.silu(a) * b) @ w_out


def short_conv_mixer(p, conv_w, w_out):
    b_g, c_g, v = jnp.split(p, 3, axis=-1)
    u = c_g * v
    L = u.shape[1]
    up = jnp.pad(u, ((0, 0), (CONV_WIDTH - 1, 0), (0, 0)))
    y = conv_w[0] * up[:, 0:L]
    for k in range(1, CONV_WIDTH):
        y = y + conv_w[k] * up[:, k:k + L]
    return (b_g * y) @ w_out


def s5_mixer(u, lam_re, lam_im, log_dt, b_re, b_im, c_re, c_im, d_skip, w_glu):
    f32 = jnp.float32
    Bsz, L, W = u.shape
    uf = u.astype(f32).reshape(Bsz, L, SSM_GROUPS, SSM_GROUP)
    lr = jnp.minimum(lam_re.astype(f32), LAMBDA_RE_MAX)
    li = lam_im.astype(f32)
    dt = jnp.exp(log_dt.astype(f32))[:, None]
    mag = jnp.exp(lr * dt)
    ab_re = mag * jnp.cos(li * dt)
    ab_im = mag * jnp.sin(li * dt)
    den = lr * lr + li * li
    nr = ab_re - 1.0
    f_re = (nr * lr + ab_im * li) / den
    f_im = (ab_im * lr - nr * li) / den
    br = b_re.astype(f32)
    bi = b_im.astype(f32)
    bb_re = f_re[..., None] * br - f_im[..., None] * bi
    bb_im = f_re[..., None] * bi + f_im[..., None] * br
    bu_re = jnp.einsum('blgh,gph->blgp', uf, bb_re)
    bu_im = jnp.einsum('blgh,gph->blgp', uf, bb_im)
    a_re = jnp.broadcast_to(ab_re, bu_re.shape)
    a_im = jnp.broadcast_to(ab_im, bu_im.shape)

    def combine(e1, e2):
        a1r, a1i, b1r, b1i = e1
        a2r, a2i, b2r, b2i = e2
        return (a2r * a1r - a2i * a1i,
                a2r * a1i + a2i * a1r,
                a2r * b1r - a2i * b1i + b2r,
                a2r * b1i + a2i * b1r + b2i)

    _, _, s_re, s_im = lax.associative_scan(combine, (a_re, a_im, bu_re, bu_im), axis=1)
    y = (jnp.einsum('blgp,ghp->blgh', s_re, c_re.astype(f32))
         - jnp.einsum('blgp,ghp->blgh', s_im, c_im.astype(f32)))
    y = y.reshape(Bsz, L, W) + d_skip.astype(f32) * uf.reshape(Bsz, L, W)
    y = jax.nn.gelu(y).astype(u.dtype)
    a, g = jnp.split(y @ w_glu, 2, axis=-1)
    return a * jax.nn.sigmoid(g)


def pool_mixer(u, w_pool, pool_scale, w_out):
    f32 = jnp.float32
    Bsz, L, W = u.shape
    uf = u.astype(f32).reshape(Bsz, L, len(POOL_WINDOWS), POOL_GROUP)
    cs = jnp.cumsum(uf, axis=1)
    pos = jnp.arange(L)
    outs = []
    for gi, w in enumerate(POOL_WINDOWS):
        cg = cs[:, :, gi]
        lag = jnp.pad(cg, ((0, 0), (w, 0), (0, 0)))[:, :L]
        cnt = jnp.minimum(pos + 1, w).astype(f32)[None, :, None]
        outs.append((cg - lag) / cnt - uf[:, :, gi])
    pooled = jnp.stack(outs, axis=2)
    mixed = jnp.einsum('blgc,gcd->blgd', pooled, w_pool.astype(f32)).reshape(Bsz, L, W)
    return (mixed * pool_scale.astype(f32)).astype(u.dtype) @ w_out


def stick_breaking_attention(p, w_out):
    f32 = jnp.float32
    Bsz, L, _ = p.shape
    q, k, v = jnp.split(p, 3, axis=-1)
    q = q.astype(f32).reshape(Bsz, L, SB_HEADS, SB_HEAD_DIM) * (SB_HEAD_DIM ** -0.5)
    k = k.astype(f32).reshape(Bsz, L, SB_HEADS, SB_HEAD_DIM)
    v = v.astype(f32).reshape(Bsz, L, SB_HEADS, SB_HEAD_DIM)
    outs = []
    for start in range(0, L, Q_BLOCK):
        end = start + Q_BLOCK
        z = jnp.einsum('bqhd,bkhd->bhqk', q[:, start:end], k[:, :end])
        t_idx = jnp.arange(start, end)[:, None]
        s_idx = jnp.arange(end)[None, :]
        mask = s_idx < t_idx
        log_keep = jnp.where(mask, jax.nn.log_sigmoid(-z), 0.0)
        log_w = jax.nn.log_sigmoid(z) + lax.cumsum(log_keep, axis=3, reverse=True) - log_keep
        a = jnp.where(mask, jnp.exp(log_w), 0.0)
        outs.append(jnp.einsum('bhqk,bkhd->bqhd', a, v[:, :end]))
    o = jnp.concatenate(outs, axis=1).reshape(Bsz, L, MIX_WIDTH).astype(p.dtype)
    return o @ w_out


def setup_inputs(seed: int = 0) -> dict:
    key = jax.random.key(seed)
    ks = jax.random.split(key, 32)
    f32 = jnp.float32

    def nrm(k, shape, fan_in, gain=1.0):
        return jax.random.normal(k, shape, f32) * (gain * fan_in ** -0.5)

    W = MIX_WIDTH
    x = jax.random.normal(ks[0], (BATCH, SEQ, D_MODEL), f32)
    c = jax.random.normal(ks[1], (BATCH, D_MODEL), f32)
    w_ada = nrm(ks[2], (DEPTH, D_MODEL, N_SUB * 3 * D_MODEL), D_MODEL, 0.1)
    b_ada = 0.01 * jax.random.normal(ks[3], (DEPTH, N_SUB * 3 * D_MODEL), f32)
    g_pre = 1.0 + 0.02 * jax.random.normal(ks[4], (DEPTH, N_SUB, D_MODEL), f32)
    g_post = 1.0 + 0.02 * jax.random.normal(ks[5], (DEPTH, N_SUB, D_MODEL), f32)
    w_ff_in = nrm(ks[6], (DEPTH, 2, D_MODEL, 2 * D_FF), D_MODEL)
    w_ff_out = nrm(ks[7], (DEPTH, 2, D_FF, D_MODEL), D_FF)
    w_in = nrm(ks[8], (DEPTH, D_MODEL, IN_COLS), D_MODEL)
    conv_w = nrm(ks[9], (DEPTH, CONV_WIDTH, W), CONV_WIDTH)
    w_conv_out = nrm(ks[10], (DEPTH, W, D_MODEL), W)
    lam_re = -0.5 + 0.01 * jax.random.normal(ks[11], (DEPTH, SSM_GROUPS, SSM_STATE), f32)
    lam_im = (math.pi * jnp.arange(SSM_STATE, dtype=f32))[None, None, :] \
        + 0.01 * jax.random.normal(ks[12], (DEPTH, SSM_GROUPS, SSM_STATE), f32)
    log_dt = jax.random.uniform(ks[13], (DEPTH, SSM_GROUPS), f32,
                                math.log(DT_MIN), math.log(DT_MAX))
    ssm_b_re = nrm(ks[14], (DEPTH, SSM_GROUPS, SSM_STATE, SSM_GROUP), 2 * SSM_GROUP)
    ssm_b_im = nrm(ks[15], (DEPTH, SSM_GROUPS, SSM_STATE, SSM_GROUP), 2 * SSM_GROUP)
    ssm_c_re = nrm(ks[16], (DEPTH, SSM_GROUPS, SSM_GROUP, SSM_STATE), 2 * SSM_STATE)
    ssm_c_im = nrm(ks[17], (DEPTH, SSM_GROUPS, SSM_GROUP, SSM_STATE), 2 * SSM_STATE)
    ssm_d = jax.random.normal(ks[18], (DEPTH, W), f32)
    w_glu = nrm(ks[19], (DEPTH, W, 2 * D_MODEL), W)
    w_pool = nrm(ks[20], (DEPTH, len(POOL_WINDOWS), POOL_GROUP, POOL_GROUP), POOL_GROUP)
    pool_scale = 1.0 + 0.1 * jax.random.normal(ks[21], (DEPTH, W), f32)
    w_pool_out = nrm(ks[22], (DEPTH, W, D_MODEL), W)
    w_sb_out = nrm(ks[23], (DEPTH, W, D_MODEL), W)
    w_out = nrm(ks[24], (DEPTH, D_MODEL, D_MODEL), D_MODEL)
    return {"x": x, "c": c, "w_ada": w_ada, "b_ada": b_ada, "g_pre": g_pre, "g_post": g_post,
            "w_ff_in": w_ff_in, "w_ff_out": w_ff_out, "w_in": w_in, "conv_w": conv_w,
            "w_conv_out": w_conv_out, "lam_re": lam_re, "lam_im": lam_im, "log_dt": log_dt,
            "ssm_b_re": ssm_b_re, "ssm_b_im": ssm_b_im, "ssm_c_re": ssm_c_re, "ssm_c_im": ssm_c_im,
            "ssm_d": ssm_d, "w_glu": w_glu, "w_pool": w_pool, "pool_scale": pool_scale,
            "w_pool_out": w_pool_out, "w_sb_out": w_sb_out, "w_out": w_out}


def reference(x, c, w_ada, b_ada, g_pre, g_post, w_ff_in, w_ff_out, w_in, conv_w,
              w_conv_out, lam_re, lam_im, log_dt, ssm_b_re, ssm_b_im, ssm_c_re, ssm_c_im,
              ssm_d, w_glu, w_pool, pool_scale, w_pool_out, w_sb_out, w_out):
    Bsz, L, D = x.shape
    c_act = jax.nn.silu(c)
    for l in range(DEPTH):
        ada = (c_act @ w_ada[l] + b_ada[l]).reshape(Bsz, N_SUB, 3, D)

        h = modulate(rmsnorm(x, g_pre[l, 0]), ada[:, 0, 0], ada[:, 0, 1])
        f = swiglu_ffn(h, w_ff_in[l, 0], w_ff_out[l, 0])
        x = x + FFN_RES_WEIGHT * (1.0 + ada[:, 0, 2])[:, None, :] * rmsnorm(f, g_post[l, 0])

        h = modulate(rmsnorm(x, g_pre[l, 1]), ada[:, 1, 0], ada[:, 1, 1])
        p = h @ w_in[l]
        p_conv, p_ssm, p_pool, p_sb, p_gate = jnp.split(p, IN_SPLITS, axis=-1)
        y_a = short_conv_mixer(p_conv, conv_w[l], w_conv_out[l])
        y_b = s5_mixer(p_ssm, lam_re[l], lam_im[l], log_dt[l], ssm_b_re[l], ssm_b_im[l],
                       ssm_c_re[l], ssm_c_im[l], ssm_d[l], w_glu[l])
        y_c = pool_mixer(p_pool, w_pool[l], pool_scale[l], w_pool_out[l])
        y_d = stick_breaking_attention(p_sb, w_sb_out[l])
        gates = jax.nn.sigmoid(p_gate).reshape(Bsz, L, N_BRANCH, D)
        merged = (gates[:, :, 0] * y_a + gates[:, :, 1] * y_b
                  + gates[:, :, 2] * y_c + gates[:, :, 3] * y_d)
        m = merged @ w_out[l]
        x = x + (1.0 + ada[:, 1, 2])[:, None, :] * rmsnorm(m, g_post[l, 1])

        h = modulate(rmsnorm(x, g_pre[l, 2]), ada[:, 2, 0], ada[:, 2, 1])
        f = swiglu_ffn(h, w_ff_in[l, 1], w_ff_out[l, 1])
        x = x + FFN_RES_WEIGHT * (1.0 + ada[:, 2, 2])[:, None, :] * rmsnorm(f, g_post[l, 2])
    return x
```

```cpp
#include <hip/hip_runtime.h>
#include <hip/hip_cooperative_groups.h>
#include <cstdio>
#include <cstdint>
namespace cg = cooperative_groups;

#ifndef MK_PER_PHASE
#define MK_PER_PHASE 0
#endif
#ifndef PROBE_SYNC2
#define PROBE_SYNC2 0
#endif
#ifndef SB_EARLY_EXIT
#define SB_EARLY_EXIT 1
#endif

#define LAS __attribute__((address_space(3)))
#define GAS __attribute__((address_space(1)))
typedef unsigned short bf16_t;
typedef short bf16x8 __attribute__((ext_vector_type(8)));
typedef short s16x4 __attribute__((ext_vector_type(4)));
typedef float f32x4 __attribute__((ext_vector_type(4)));
typedef float f32x16 __attribute__((ext_vector_type(16)));
typedef unsigned u32x4 __attribute__((ext_vector_type(4)));
typedef unsigned u32x2 __attribute__((ext_vector_type(2)));

constexpr int T_ = 16384, D_ = 1024, L_ = 2048, NB = 8, FF_ = 2816, NIN = 6144, DEPTH = 4;
constexpr float EPS_ = 1e-6f;
#ifndef MK_STOP_PH
#define MK_STOP_PH (2 + 11 * DEPTH)
#define MK_DUMP_MASK 15
#endif
constexpr int NPHASE = MK_STOP_PH;

constexpr size_t SZ_FFIN = (size_t)2 * FF_ * D_ * 2, SZ_FFOUT = (size_t)D_ * FF_ * 2, SZ_WIN = (size_t)NIN * D_ * 2;
constexpr size_t SZ_BR = (size_t)D_ * 256 * 2, SZ_GLU = (size_t)2048 * 256 * 2, SZ_WOUT = (size_t)D_ * D_ * 2;
constexpr size_t SZ_TM = (size_t)16 * 256 * 384 * 2, SZ_WZ = (size_t)16 * 256 * 256 * 2;
constexpr size_t OFF_FFIN0 = 0, OFF_FFIN1 = OFF_FFIN0 + SZ_FFIN, OFF_FFOUT0 = OFF_FFIN1 + SZ_FFIN, OFF_FFOUT1 = OFF_FFOUT0 + SZ_FFOUT;
constexpr size_t OFF_WIN = OFF_FFOUT1 + SZ_FFOUT, OFF_WCONV = OFF_WIN + SZ_WIN, OFF_WPOOL = OFF_WCONV + SZ_BR, OFF_WSB = OFF_WPOOL + SZ_BR;
constexpr size_t OFF_WGLU = OFF_WSB + SZ_BR, OFF_WOUT = OFF_WGLU + SZ_GLU, OFF_TM = OFF_WOUT + SZ_WOUT, OFF_WZ = OFF_TM + SZ_TM;
constexpr size_t LAYER_W = OFF_WZ + SZ_WZ;
constexpr size_t MiB = 1u << 20;
constexpr size_t WS_W = 0;
constexpr size_t WS_ADA = ((DEPTH * LAYER_W + MiB - 1) / MiB) * MiB;
constexpr size_t WS_APOW = WS_ADA + 2 * MiB;
constexpr size_t WS_BB = WS_APOW + 1 * MiB;
constexpr size_t WS_KERN = WS_BB + 1 * MiB;
constexpr size_t WS_H = WS_KERN + 2 * MiB;
constexpr size_t WS_P = WS_H + (size_t)T_ * D_ * 2;
constexpr size_t WS_F = WS_P + (size_t)T_ * NIN * 2;
constexpr size_t WS_ACAT = WS_F + (size_t)T_ * D_ * 4;
constexpr size_t WS_ASSM = WS_ACAT + (size_t)T_ * D_ * 2;
constexpr size_t WS_Z = WS_ASSM + (size_t)16384 * 384 * 2;
constexpr size_t WS_VT = WS_Z + (size_t)16384 * 256 * 4;
constexpr size_t WS_XB = WS_VT + (size_t)256 * T_ * 2;
constexpr size_t WS_BAR = WS_XB + (size_t)T_ * D_ * 2;
constexpr size_t BAR_BYTES = 16384;
constexpr size_t WS_END = WS_BAR + BAR_BYTES;

constexpr int LDS_BYTES = 131072 + 1024;

typedef float f32x2_t __attribute__((ext_vector_type(2))); typedef __bf16 bf16x2_t __attribute__((ext_vector_type(2)));
__device__ __forceinline__ unsigned cvt_pk_bf16(float lo, float hi) { f32x2_t v = {lo, hi}; bf16x2_t b = __builtin_convertvector(v, bf16x2_t); return __builtin_bit_cast(unsigned, b); }
__device__ __forceinline__ float bf_lo(unsigned u) { return __uint_as_float(u << 16); }
__device__ __forceinline__ float bf_hi(unsigned u) { return __uint_as_float(u & 0xffff0000u); }
__device__ __forceinline__ float sigmoidf_(float x) { return __builtin_amdgcn_rcpf(1.0f + __expf(-x)); }
__device__ __forceinline__ float shfl_xor_(float v, int m, int lane) { return __int_as_float(__builtin_amdgcn_ds_bpermute((lane ^ m) << 2, __float_as_int(v))); }
__device__ __forceinline__ float wave_sum(float v, int lane) {
#pragma unroll
    for (int o = 1; o < 64; o <<= 1) v += shfl_xor_(v, o, lane);
    return v;
}
__device__ __forceinline__ void unpack8(u32x4 w, float* o) { o[0] = bf_lo(w.x); o[1] = bf_hi(w.x); o[2] = bf_lo(w.y); o[3] = bf_hi(w.y); o[4] = bf_lo(w.z); o[5] = bf_hi(w.z); o[6] = bf_lo(w.w); o[7] = bf_hi(w.w); }
__device__ __forceinline__ u32x4 pack8(const float* v) { u32x4 w; w.x = cvt_pk_bf16(v[0], v[1]); w.y = cvt_pk_bf16(v[2], v[3]); w.z = cvt_pk_bf16(v[4], v[5]); w.w = cvt_pk_bf16(v[6], v[7]); return w; }

namespace pg8 {
constexpr int BM = 256, BK = 64, HALF = 128, HTB = HALF * BK * 2, STAGE_BYTES = 8 * HTB, NXCD = 8, WGM = 8;
__host__ __device__ __forceinline__ int lds_byte(int r, int c) { const int st = (r >> 4) * 2 + (c >> 5), rr = r & 15, cc = c & 31, ob = rr * 64 + cc * 2; return st * 1024 + (ob ^ (((ob >> 9) & 1) << 5)); }
__host__ __device__ __forceinline__ void stage_rc(int b, int& R, int& C) { const int st = b / 1024, sb = b % 1024, swz = sb ^ (((sb >> 9) & 1) << 5); R = (st >> 1) * 16 + swz / 64; C = (st & 1) * 32 + (swz % 64) / 2; }
__host__ __device__ __forceinline__ int perm32(int rho) { const int n = rho >> 4, i = rho & 15; return 8 * (i >> 2) + 4 * n + (i & 3); }

struct Unit { int pm, pn, sel; };
struct Gemm { const bf16_t* A; const bf16_t* Bt; int K, lda, ldb, bshift; size_t bgs; };

struct GOrder {
    int nM, nN, nwg, G, c, skip, pair, branch;
    __device__ void init(int M, int N, int G_, int c_) { nM = M / BM; nN = N / BM; nwg = nM * nN; G = G_; c = c_; skip = -1; pair = 0; branch = 0; }
    __device__ bool next(int i, Unit& u) const {
        const int ii = branch ? (i / 5) : (pair ? (i >> 1) : i);
        const long L = (long)ii * G + c; if (L >= nwg) return false;
        int wgid = (int)L; { const int q = nwg / NXCD, r = nwg % NXCD, xcd = wgid % NXCD, off = wgid / NXCD; wgid = (xcd < r ? xcd * (q + 1) : r * (q + 1) + (xcd - r) * q) + off; }
        const int nig = WGM * nN, gid = wgid / nig, fm = gid * WGM, gsz = (nM - fm) < WGM ? (nM - fm) : WGM;
        u.pm = fm + ((wgid % nig) % gsz); u.pn = (wgid % nig) / gsz; u.sel = 0;
        if (skip >= 0 && u.pn >= skip) u.pn++;
        if (pair) u.pn = 2 * u.pn + (i & 1);
        if (branch) { u.sel = i - 5 * ii; if (u.sel >= 3) u.pn = 2 * u.pn + (u.sel - 3); }
        return true;
    }
    __device__ __forceinline__ size_t aoff(const Unit& u) const { return branch ? (u.sel == 0 ? 0u : (u.sel == 1 ? 1024u : (u.sel == 2 ? 1536u : 512u))) : 0u; }
    __device__ __forceinline__ size_t boff(const Unit& u) const { return branch ? (size_t)(u.sel < 3 ? u.sel : 3) * SZ_BR : 0u; }
};

template <class Epi, class Sched, bool ALIGN_EPI>
__device__ __forceinline__ void gemm_phase(LAS unsigned char* lds, const Gemm g, const Sched& S, const Epi& E, const int tid) {
    const int wid = __builtin_amdgcn_readfirstlane(tid >> 6), lane = tid & 63, wr = wid >> 2, wc = wid & 3, fr = lane & 15, fq = lane >> 4;
    const int K = g.K, nt = K / BK;
    unsigned voffA[2], voffB[2];
#pragma unroll
    for (int i = 0; i < 2; ++i) { int R, C; stage_rc(tid * 16 + i * 8192, R, C); const int Rb = Epi::PERM ? ((R & ~31) + perm32(R & 31)) : R;
        voffA[i] = (unsigned)(R * g.lda + C) * 2u; voffB[i] = (unsigned)(Rb * g.ldb + C) * 2u; }
    const size_t kstep = (size_t)(BK * 2);
    const size_t hsA = (size_t)HALF * g.lda * 2, hsB = (size_t)HALF * g.ldb * 2;
    const size_t tsA = 2 * hsA, tsB = 2 * hsB;
    const unsigned ldsw = (unsigned)wid * 1024u;
    const int aoff = lds_byte(wr * 64 + fr, fq * 8), boff = lds_byte(wc * 32 + fr, fq * 8);
#define PG8_SA(b, h) (((b) * 2 + (h)) * HTB)
#define PG8_SB(b, h) ((4 + (b) * 2 + (h)) * HTB)
#define PG8_STAGE(bufoff, gbase, voff) do { _Pragma("unroll") for (int _i = 0; _i < 2; ++_i) \
        __builtin_amdgcn_global_load_lds((const unsigned*)((const char*)(gbase) + (voff)[_i]), (LAS unsigned*)(lds + (bufoff) + ldsw + _i * 8192), 16, 0, 0); } while (0)
#define PG8_LDA(dst, b, h) do { _Pragma("unroll") for (int m = 0; m < 4; ++m) _Pragma("unroll") for (int k = 0; k < 2; ++k) dst[m][k] = *(const LAS bf16x8*)(lds + PG8_SA(b, h) + aoff + m * 2048 + k * 1024); } while (0)
#define PG8_LDB(dst, b, h) do { _Pragma("unroll") for (int n = 0; n < 2; ++n) _Pragma("unroll") for (int k = 0; k < 2; ++k) dst[n][k] = *(const LAS bf16x8*)(lds + PG8_SB(b, h) + boff + n * 2048 + k * 1024); } while (0)
#define PG8_MMA(ai, bj, At, Bt) do { __builtin_amdgcn_s_setprio(1); _Pragma("unroll") for (int m = 0; m < 4; ++m) _Pragma("unroll") for (int n = 0; n < 2; ++n) _Pragma("unroll") for (int k = 0; k < 2; ++k) \
        acc[ai][bj][m][n] = __builtin_amdgcn_mfma_f32_16x16x32_bf16(Bt[n][k], At[m][k], acc[ai][bj][m][n], 0, 0, 0); __builtin_amdgcn_s_setprio(0); } while (0)
#define PG8_WAIT_V(n) asm volatile("s_waitcnt vmcnt(" #n ")" ::: "memory")
#define PG8_WAIT_L(n) asm volatile("s_waitcnt lgkmcnt(" #n ")" ::: "memory")
#define PG8_BAR __builtin_amdgcn_s_barrier()
#define PG8_SCHED __builtin_amdgcn_sched_barrier(0)
    Unit cur, nxt; int ui = 0;
    if (!S.next(0, cur)) return;
    f32x4 acc[2][2][4][2];
#pragma unroll
    for (int a = 0; a < 2; ++a)
#pragma unroll
        for (int b = 0; b < 2; ++b)
#pragma unroll
            for (int m = 0; m < 4; ++m)
#pragma unroll
                for (int n = 0; n < 2; ++n) acc[a][b][m][n] = (f32x4){0.f, 0.f, 0.f, 0.f};
    bf16x8 At[4][2], B0[2][2], B1[2][2];
    const char* cA = (const char*)g.A + (size_t)cur.pm * tsA + S.aoff(cur);
    const char* cB = (const char*)g.Bt + (size_t)cur.pn * tsB + (size_t)(cur.pm >> g.bshift) * g.bgs * 2 + S.boff(cur);
    PG8_STAGE(PG8_SB(0, 0), cB, voffB); PG8_STAGE(PG8_SB(0, 1), cB + hsB, voffB); PG8_STAGE(PG8_SA(0, 0), cA, voffA); PG8_STAGE(PG8_SA(0, 1), cA + hsA, voffA);
    if (wr == 1) PG8_BAR;
    PG8_WAIT_V(2); PG8_BAR;
    PG8_STAGE(PG8_SB(1, 0), cB + kstep, voffB); PG8_STAGE(PG8_SA(1, 0), cA + kstep, voffA); PG8_STAGE(PG8_SB(1, 1), cB + hsB + kstep, voffB);
    PG8_WAIT_V(6); PG8_BAR;
    for (;;) {
        const bool has_next = S.next(ui + 1, nxt);
        const char* nA = has_next ? (const char*)g.A + (size_t)nxt.pm * tsA + S.aoff(nxt) : cA;
        const char* nB = has_next ? (const char*)g.Bt + (size_t)nxt.pn * tsB + (size_t)(nxt.pm >> g.bshift) * g.bgs * 2 + S.boff(nxt) : cB;
        for (int t = 0; t < nt; t += 2) {
            const bool last = (t == nt - 2);
            const char* a1 = cA + (size_t)(t + 1) * kstep;
            const char* a2 = last ? nA : cA + (size_t)(t + 2) * kstep; const char* b2 = last ? nB : cB + (size_t)(t + 2) * kstep;
            const char* a3 = a2 + kstep; const char* b3 = b2 + kstep;
            PG8_LDB(B0, 0, 0); PG8_LDB(B1, 0, 1); PG8_SCHED; PG8_LDA(At, 0, 0); PG8_STAGE(PG8_SA(1, 1), a1 + hsA, voffA);
            PG8_WAIT_V(8); PG8_WAIT_L(0); PG8_BAR; PG8_MMA(0, 0, At, B0); PG8_MMA(0, 1, At, B1); PG8_BAR; PG8_SCHED;
            PG8_LDA(At, 0, 1); PG8_STAGE(PG8_SB(0, 0), b2, voffB); PG8_STAGE(PG8_SB(0, 1), b2 + hsB, voffB); PG8_STAGE(PG8_SA(0, 0), a2, voffA);
            PG8_WAIT_V(8); PG8_WAIT_L(0); PG8_BAR; PG8_MMA(1, 0, At, B0); PG8_MMA(1, 1, At, B1); PG8_BAR; PG8_SCHED;
            PG8_LDB(B0, 1, 0); PG8_LDB(B1, 1, 1); PG8_SCHED; PG8_LDA(At, 1, 0); PG8_STAGE(PG8_SA(0, 1), a2 + hsA, voffA);
            PG8_WAIT_V(8); PG8_WAIT_L(0); PG8_BAR; PG8_MMA(0, 0, At, B0); PG8_MMA(0, 1, At, B1); PG8_BAR; PG8_SCHED;
            PG8_LDA(At, 1, 1); PG8_STAGE(PG8_SB(1, 0), b3, voffB); PG8_STAGE(PG8_SB(1, 1), b3 + hsB, voffB); PG8_STAGE(PG8_SA(1, 0), a3, voffA);
            PG8_WAIT_V(8); PG8_WAIT_L(0); PG8_BAR; PG8_MMA(1, 0, At, B0); PG8_MMA(1, 1, At, B1); PG8_BAR; PG8_SCHED;
        }
        if constexpr (ALIGN_EPI) { if (wr == 0) PG8_BAR; }
        E(acc, cur, wr, wc, fr, fq);
        if (!has_next) break;
#pragma unroll
        for (int a = 0; a < 2; ++a)
#pragma unroll
            for (int b = 0; b < 2; ++b)
#pragma unroll
                for (int m = 0; m < 4; ++m)
#pragma unroll
                    for (int n = 0; n < 2; ++n) acc[a][b][m][n] = (f32x4){0.f, 0.f, 0.f, 0.f};
        cur = nxt; cA = nA; cB = nB; ++ui;
        if constexpr (ALIGN_EPI) { if (wr == 1) PG8_BAR; }
    }
    PG8_WAIT_V(0);
    if constexpr (!ALIGN_EPI) { if (wr == 0) PG8_BAR; }
    PG8_BAR;
#undef PG8_SA
#undef PG8_SB
#undef PG8_STAGE
#undef PG8_LDA
#undef PG8_LDB
#undef PG8_MMA
#undef PG8_WAIT_V
#undef PG8_WAIT_L
#undef PG8_BAR
#undef PG8_SCHED
}

typedef const f32x4 (&AccRef)[2][2][4][2];
enum { EM_FB16 = 0, EM_BF16 = 1, EM_SWIGLU = 2, EM_MIXIN = 3, EM_BR0 = 4, EM_BR1 = 5, EM_GLU = 6, EM_S5Y = 7, EM_F32Z = 8, EM_BR2 = 9, EM_BRANCH = 10 };
struct GEpi {
    static constexpr bool PERM = true;
    int mode_; int gcol_; unsigned char* ws; const float* dskip;
    __device__ __forceinline__ void operator()(AccRef acc, const Unit& u, int wr, int wc, int fr, int fq) const {
        const int mode = mode_ == EM_BRANCH ? (u.sel == 0 ? EM_BR0 : (u.sel == 1 ? EM_BR1 : (u.sel == 2 ? EM_BR2 : EM_GLU))) : mode_;
        const int gcol = mode_ == EM_BRANCH ? (u.sel == 0 ? 2048 : (u.sel == 1 ? 4096 : 5120)) : gcol_;
        float* of = (float*)(ws + WS_Z); const float* pf = dskip;
        bf16_t* ob = (bf16_t*)(ws + (mode == EM_BF16 ? WS_VT : (mode == EM_GLU || mode == EM_BR2 ? WS_H : (mode == EM_S5Y ? WS_ACAT : (mode == EM_FB16 || mode == EM_BR0 ? WS_F : (mode == EM_BR1 ? WS_F + (size_t)T_ * D_ * 2 : WS_P))))));
        bf16_t* ob2 = (bf16_t*)(ws + WS_ASSM); const bf16_t* pb = (const bf16_t*)(ws + (mode == EM_S5Y ? WS_ASSM : WS_P));
        const int ldc = mode == EM_F32Z ? 256 : (mode == EM_BF16 ? T_ : (mode == EM_SWIGLU ? FF_ : D_));
        const int row0 = u.pm * BM + wr * 64 + fr;
        if (mode == EM_F32Z) {
#pragma unroll
            for (int ai = 0; ai < 2; ++ai)
#pragma unroll
                for (int m = 0; m < 4; ++m) { float* rowp = of + (size_t)(row0 + ai * HALF + m * 16) * ldc + u.pn * BM + wc * 32 + 8 * fq;
#pragma unroll
                    for (int bj = 0; bj < 2; ++bj) { *(f32x4*)(rowp + bj * HALF) = acc[ai][bj][m][0]; *(f32x4*)(rowp + bj * HALF + 4) = acc[ai][bj][m][1]; } }
        } else if (mode == EM_BF16 || mode == EM_FB16) {
#pragma unroll
            for (int ai = 0; ai < 2; ++ai)
#pragma unroll
                for (int m = 0; m < 4; ++m) { bf16_t* rowp = ob + (size_t)(row0 + ai * HALF + m * 16) * ldc + u.pn * BM + wc * 32 + 8 * fq;
#pragma unroll
                    for (int bj = 0; bj < 2; ++bj) { const f32x4 v0 = acc[ai][bj][m][0], v1 = acc[ai][bj][m][1];
                        u32x4 w; w.x = cvt_pk_bf16(v0[0], v0[1]); w.y = cvt_pk_bf16(v0[2], v0[3]); w.z = cvt_pk_bf16(v1[0], v1[1]); w.w = cvt_pk_bf16(v1[2], v1[3]);
                        *(u32x4*)(rowp + bj * HALF) = w; } }
        } else if (mode == EM_SWIGLU) {
#pragma unroll
            for (int ai = 0; ai < 2; ++ai)
#pragma unroll
                for (int m = 0; m < 4; ++m) { bf16_t* rowp = ob + (size_t)(row0 + ai * HALF + m * 16) * ldc + u.pn * HALF + wc * 32 + 8 * fq;
                    float v[8];
#pragma unroll
                    for (int n = 0; n < 2; ++n)
#pragma unroll
                        for (int i = 0; i < 4; ++i) { const float a = acc[ai][0][m][n][i], b = acc[ai][1][m][n][i]; v[4 * n + i] = a * sigmoidf_(a) * b; }
                    *(u32x4*)rowp = pack8(v); }
        } else if (mode == EM_MIXIN) {
            const bool ssm = u.pn == 3;
#pragma unroll
            for (int ai = 0; ai < 2; ++ai)
#pragma unroll
                for (int m = 0; m < 4; ++m) { const int r = row0 + ai * HALF + m * 16;
#pragma unroll
                    for (int bj = 0; bj < 2; ++bj) { const int cl = bj * HALF + wc * 32 + 8 * fq;
                        float v[8];
#pragma unroll
                        for (int n = 0; n < 2; ++n)
#pragma unroll
                            for (int i = 0; i < 4; ++i) v[4 * n + i] = acc[ai][bj][m][n][i];
                        bf16_t* dst = ssm ? ob2 + ((size_t)((cl >> 4) * 1024 + (r >> 4))) * 384 + (r & 15) * 16 + (cl & 15)
                                          : ob + (size_t)r * NIN + u.pn * BM + cl;
                        *(u32x4*)dst = pack8(v); } }
        } else if (mode == EM_BR0 || mode == EM_BR1 || mode == EM_BR2) {
#pragma unroll
            for (int ai = 0; ai < 2; ++ai)
#pragma unroll
                for (int m = 0; m < 4; ++m) { const int r = row0 + ai * HALF + m * 16;
#pragma unroll
                    for (int bj = 0; bj < 2; ++bj) { const int col = u.pn * BM + bj * HALF + wc * 32 + 8 * fq;
                        float gt[8]; unpack8(*(const u32x4*)(pb + (size_t)r * NIN + gcol + col), gt);
                        float v[8];
#pragma unroll
                        for (int i = 0; i < 4; ++i) { v[i] = gt[i] * acc[ai][bj][m][0][i]; v[4 + i] = gt[4 + i] * acc[ai][bj][m][1][i]; }
                        *(u32x4*)(ob + (size_t)r * D_ + col) = pack8(v); } }
        } else if (mode == EM_GLU) {
            const int col = u.pn * HALF + wc * 32 + 8 * fq;
            const bf16_t* g0 = (const bf16_t*)(ws + WS_F); const bf16_t* g1 = g0 + (size_t)T_ * D_;
#pragma unroll
            for (int ai = 0; ai < 2; ++ai)
#pragma unroll
                for (int m = 0; m < 4; ++m) { const int r = row0 + ai * HALF + m * 16;
                    float gt[8], p0[8], p1[8], p2[8];
                    unpack8(*(const u32x4*)(pb + (size_t)r * NIN + 2048 + 1024 + col), gt);
                    unpack8(*(const u32x4*)(g0 + (size_t)r * D_ + col), p0); unpack8(*(const u32x4*)(g1 + (size_t)r * D_ + col), p1); unpack8(*(const u32x4*)(ob + (size_t)r * D_ + col), p2);
                    float v[8];
#pragma unroll
                    for (int n = 0; n < 2; ++n)
#pragma unroll
                        for (int i = 0; i < 4; ++i) { const float a = acc[ai][0][m][n][i], g = acc[ai][1][m][n][i];
                            v[4 * n + i] = (p0[4 * n + i] + p1[4 * n + i]) + (p2[4 * n + i] + gt[4 * n + i] * a * sigmoidf_(g)); }
                    *(u32x4*)(ob + (size_t)r * D_ + col) = pack8(v); }
        } else {
#pragma unroll
            for (int ai = 0; ai < 2; ++ai)
#pragma unroll
                for (int m = 0; m < 4; ++m) { const int r = row0 + ai * HALF + m * 16, g = r >> 10, chunk = r & 1023;
#pragma unroll
                    for (int bj = 0; bj < 2; ++bj) { const int cl = bj * HALF + wc * 32 + 8 * fq, ii = cl >> 4, h0 = cl & 15;
                        float uu[8]; unpack8(*(const u32x4*)(pb + (size_t)r * 384 + cl), uu);
                        const f32x4 d0 = *(const f32x4*)(pf + g * 16 + h0), d1 = *(const f32x4*)(pf + g * 16 + h0 + 4);
                        float v[8];
#pragma unroll
                        for (int n = 0; n < 2; ++n)
#pragma unroll
                            for (int i = 0; i < 4; ++i) { const float y = acc[ai][bj][m][n][i] + (n == 0 ? d0[i] : d1[i]) * uu[4 * n + i];
                                v[4 * n + i] = y * sigmoidf_(1.5957691216f * (y + 0.044715f * y * y * y)); }
                        *(u32x4*)(ob + (size_t)(chunk * 16 + ii) * D_ + 256 + g * 16 + h0) = pack8(v); } }
        }
    }
};
}

#define XB_TMO      128
#define XB_XCNT(j)  (256  + 64 * (j))
#define XB_XSUB(j)  (1280 + 64 * (j))
#define XB_XGEN(j)  (2304 + 64 * (j))
#define XB_TOP      3328
#define XB_TOPGEN   3392
#define XCD_BAR_WORDS 3456
#define XB_SPIN_CAP (1u << 18)

__device__ __forceinline__ unsigned xb_ld(unsigned* p)              { return __hip_atomic_load(p, __ATOMIC_RELAXED, __HIP_MEMORY_SCOPE_AGENT); }
__device__ __forceinline__ unsigned xb_add(unsigned* p, unsigned v) { return __hip_atomic_fetch_add(p, v, __ATOMIC_RELAXED, __HIP_MEMORY_SCOPE_AGENT); }
__device__ __forceinline__ unsigned xb_xcc_id() { return (unsigned)__builtin_amdgcn_s_getreg((3 << 11) | 20) & 0xFu; }
#define XB_SPIN(cond, bar) do { unsigned _sp = 0; while (cond) { __builtin_amdgcn_s_sleep(1); \
    if ((++_sp & 255u) == 0u) { if (xb_ld(&(bar)[XB_TMO])) break; if (_sp > XB_SPIN_CAP) { atomicAdd(&(bar)[XB_TMO], 1u); break; } } } } while (0)

struct XcdBarrier {
    unsigned* bar; unsigned x;
    volatile LAS unsigned* st;
};

__device__ __forceinline__ XcdBarrier xcd_barrier_post(unsigned* bar, volatile LAS unsigned* st) {
    XcdBarrier b; b.bar = bar; b.x = xb_xcc_id(); b.st = st;
    if (threadIdx.x == 0) (void)xb_add(&bar[XB_XCNT(b.x)], 1u);
    return b;
}
__device__ __forceinline__ void xcd_barrier_complete(unsigned* bar, unsigned x, unsigned& nloc, unsigned& nx) {
    const unsigned G = gridDim.x * gridDim.y * gridDim.z;
    unsigned sum, cnt, mine, sp = 0u;
    for (;;) {
        sum = 0u; cnt = 0u; mine = 0u;
#pragma unroll
        for (unsigned j = 0; j < 16; ++j) { const unsigned c = xb_ld(&bar[XB_XCNT(j)]); sum += c; cnt += (c > 0u) ? 1u : 0u; mine = (j == x) ? c : mine; }
        if (sum == G) break;
        __builtin_amdgcn_s_sleep(1);
        if ((++sp & 255u) == 0u) { if (xb_ld(&bar[XB_TMO])) break; if (sp > XB_SPIN_CAP) { atomicAdd(&bar[XB_TMO], 1u); break; } }
    }
    nloc = mine > 0u ? mine : 1u; nx = cnt > 0u ? cnt : 1u;
}

__device__ __forceinline__ void xcd_barrier(const XcdBarrier& b) {
    asm volatile("s_waitcnt vmcnt(0)" ::: "memory");
    __syncthreads();
    if (threadIdx.x == 0) {
        unsigned* bar = b.bar;
        __builtin_amdgcn_s_waitcnt(0);
        unsigned nloc = b.st[0], nx = b.st[1];
        if (nloc == 0u) { xcd_barrier_complete(bar, b.x, nloc, nx); b.st[0] = nloc; b.st[1] = nx; }
        const unsigned old = xb_add(&bar[XB_XSUB(b.x)], 1u);
        const unsigned gen = old / nloc;
        if (old + 1u == (gen + 1u) * nloc) {
            __builtin_amdgcn_fence(__ATOMIC_RELEASE, "agent");
            asm volatile("s_waitcnt vmcnt(0)" ::: "memory");
            const unsigned og = xb_add(&bar[XB_TOP], 1u);
            const unsigned tg = og / nx;
            if (og + 1u == (tg + 1u) * nx) xb_add(&bar[XB_TOPGEN], 1u);
            else XB_SPIN(xb_ld(&bar[XB_TOPGEN]) == tg, bar);
            __builtin_amdgcn_fence(__ATOMIC_ACQUIRE, "agent");
            xb_add(&bar[XB_XGEN(b.x)], 1u);
            asm volatile("s_waitcnt vmcnt(0)" ::: "memory");
        } else {
            XB_SPIN(xb_ld(&bar[XB_XGEN(b.x)]) == gen, bar);
            __builtin_amdgcn_fence(__ATOMIC_ACQUIRE, "agent");
            asm volatile("s_waitcnt vmcnt(0)" ::: "memory");
        }
    }
    __syncthreads();
}

struct Args { const float* in[25]; float* out; unsigned char* ws; int ph_lo, ph_hi, coop, pad; };
struct Ctx {
    LAS const unsigned long long* tab; unsigned char* ws;
    __device__ __forceinline__ const float* in(int i) const { const unsigned long long v = tab[i];
        const unsigned lo = __builtin_amdgcn_readfirstlane((unsigned)v), hi = __builtin_amdgcn_readfirstlane((unsigned)(v >> 32));
        return (const float*)(GAS const float*)(((unsigned long long)hi << 32) | lo); }
};

struct TItem { const float* src; bf16_t* dst; int N, K, dst_row0, k0, n0; float scale; };
constexpr int IT_FFIN = (D_ / 64) * (2 * FF_ / 32), IT_FFOUT = (FF_ / 64) * (D_ / 32), IT_WIN = (D_ / 64) * (NIN / 32);
constexpr int IT_BR = (256 / 64) * (D_ / 32), IT_GLU = (256 / 64) * (2048 / 32), IT_WOUT = (D_ / 64) * (D_ / 32), IT_POOL = 4 * 16;
constexpr int IT_TILES = 2 * IT_FFIN + 2 * IT_FFOUT + IT_WIN + 2 * IT_BR + IT_GLU + IT_WOUT;

__device__ __forceinline__ void t_decode(const Ctx& a, int it, TItem& t) {
    const int l = it / IT_TILES; int r = it % IT_TILES;
    unsigned char* wl = a.ws + WS_W + (size_t)l * LAYER_W;
    t.scale = 1.f;
    if (r < 2 * IT_FFIN) { const int s = r / IT_FFIN; r %= IT_FFIN; const int nblk = 2 * FF_ / 32, kb = r / nblk, nb = r % nblk, n0 = 32 * nb;
        const int half = n0 >= FF_, j = n0 - half * FF_;
        t.src = a.in(6) + (size_t)(l * 2 + s) * D_ * 2 * FF_; t.N = 2 * FF_; t.K = D_; t.dst = (bf16_t*)(wl + OFF_FFIN0 + s * SZ_FFIN); t.dst_row0 = 256 * (j >> 7) + 128 * half + (j & 127); t.k0 = 64 * kb; t.n0 = n0; return; }
    r -= 2 * IT_FFIN;
    if (r < 2 * IT_FFOUT) { const int s = r / IT_FFOUT; r %= IT_FFOUT; const int nblk = D_ / 32, kb = r / nblk, nb = r % nblk;
        t.src = a.in(7) + (size_t)(l * 2 + s) * FF_ * D_; t.N = D_; t.K = FF_; t.dst = (bf16_t*)(wl + OFF_FFOUT0 + s * SZ_FFOUT); t.dst_row0 = 32 * nb; t.k0 = 64 * kb; t.n0 = 32 * nb; return; }
    r -= 2 * IT_FFOUT;
    if (r < IT_WIN) { const int nblk = NIN / 32, kb = r / nblk, nb = r % nblk, n0 = 32 * nb;
        t.scale = (n0 >= 1280 && n0 < 1536) ? 0.125f : 1.f;
        t.src = a.in(8) + (size_t)l * D_ * NIN; t.N = NIN; t.K = D_; t.dst = (bf16_t*)(wl + OFF_WIN); t.dst_row0 = n0; t.k0 = 64 * kb; t.n0 = n0; return; }
    r -= IT_WIN;
    if (r < 2 * IT_BR) { const int s = r / IT_BR; r %= IT_BR; const int nblk = D_ / 32, kb = r / nblk, nb = r % nblk;
        t.src = a.in(s == 0 ? 10 : 23) + (size_t)l * 256 * D_; t.N = D_; t.K = 256; t.dst = (bf16_t*)(wl + (s == 0 ? OFF_WCONV : OFF_WSB)); t.dst_row0 = 32 * nb; t.k0 = 64 * kb; t.n0 = 32 * nb; return; }
    r -= 2 * IT_BR;
    if (r < IT_GLU) { const int nblk = 2048 / 32, kb = r / nblk, nb = r % nblk, n0 = 32 * nb; const int half = n0 >= 1024, j = n0 - half * 1024;
        t.src = a.in(19) + (size_t)l * 256 * 2048; t.N = 2048; t.K = 256; t.dst = (bf16_t*)(wl + OFF_WGLU); t.dst_row0 = 256 * (j >> 7) + 128 * half + (j & 127); t.k0 = 64 * kb; t.n0 = n0; return; }
    r -= IT_GLU;
    { const int nblk = D_ / 32, kb = r / nblk, nb = r % nblk;
        t.src = a.in(24) + (size_t)l * D_ * D_; t.N = D_; t.K = D_; t.dst = (bf16_t*)(wl + OFF_WOUT); t.dst_row0 = 32 * nb; t.k0 = 64 * kb; t.n0 = 32 * nb; }
}
__device__ __forceinline__ void t_load(const TItem& t, f32x4 (&r)[8], int lane) {
    const float* p = t.src + (size_t)(t.k0 + (lane >> 3)) * t.N + t.n0 + 4 * (lane & 7);
#pragma unroll
    for (int i = 0; i < 8; ++i) r[i] = *(const f32x4*)(p + (size_t)(8 * i) * t.N);
}
__device__ __forceinline__ void t_finish(const TItem& t, const f32x4 (&r)[8], LAS float* scr, int lane) {
    LAS float* w = scr + (lane >> 3) * 33 + 4 * (lane & 7);
#pragma unroll
    for (int i = 0; i < 8; ++i) { w[(8 * i) * 33 + 0] = r[i].x * t.scale; w[(8 * i) * 33 + 1] = r[i].y * t.scale; w[(8 * i) * 33 + 2] = r[i].z * t.scale; w[(8 * i) * 33 + 3] = r[i].w * t.scale; }
    asm volatile("s_waitcnt lgkmcnt(0)" ::: "memory");
    const int c = lane & 7;
#pragma unroll
    for (int j = 0; j < 4; ++j) { const int n = (lane >> 3) + 8 * j; const LAS float* s = scr + (8 * c) * 33 + n;
        u32x4 o; o.x = cvt_pk_bf16(s[0 * 33], s[1 * 33]); o.y = cvt_pk_bf16(s[2 * 33], s[3 * 33]); o.z = cvt_pk_bf16(s[4 * 33], s[5 * 33]); o.w = cvt_pk_bf16(s[6 * 33], s[7 * 33]);
        *(u32x4*)(t.dst + (size_t)(t.dst_row0 + n) * t.K + t.k0 + 8 * c) = o; }
    asm volatile("s_waitcnt lgkmcnt(0)" ::: "memory");
}
__device__ __forceinline__ void p0_transposes(const Ctx& a, int gw, int ngw, LAS float* scr, int lane) {
    constexpr int NT = DEPTH * IT_TILES;
    int it = gw; TItem ta, tb; f32x4 ra[8], rb[8];
    if (it < NT) { t_decode(a, it, ta); t_load(ta, ra, lane); }
    while (it < NT) {
        const int nx = it + ngw; const bool hn = nx < NT;
        if (hn) { t_decode(a, nx, tb); t_load(tb, rb, lane); }
        t_finish(ta, ra, scr, lane);
        if (hn) { ta = tb;
#pragma unroll
            for (int i = 0; i < 8; ++i) ra[i] = rb[i]; }
        it = nx;
    }
}
__device__ __forceinline__ void p0_pool_item(const Ctx& a, int it, int lane) {
    const int l = it >> 6, r = it & 63;
    unsigned char* wl = a.ws + WS_W + (size_t)l * LAYER_W;
    const int gi = r >> 4, n = (r & 15) * 64 + lane;
    const float* wp = a.in(20) + (size_t)l * 4 * 64 * 64 + (size_t)gi * 64 * 64;
    const float* ps = a.in(21) + (size_t)l * 256 + gi * 64;
    const float* wo = a.in(22) + (size_t)l * 256 * D_ + (size_t)gi * 64 * D_ + n;
    bf16_t* dst = (bf16_t*)(wl + OFF_WPOOL) + (size_t)n * 256 + gi * 64;
    float wv[64];
#pragma unroll
    for (int d = 0; d < 64; ++d) wv[d] = wo[(size_t)d * D_] * ps[d];
    for (int c8 = 0; c8 < 8; ++c8) { float v[8];
#pragma unroll
        for (int cc = 0; cc < 8; ++cc) { const float* wr_ = wp + (c8 * 8 + cc) * 64; float s = 0.f;
#pragma unroll
            for (int d = 0; d < 64; ++d) s += wr_[d] * wv[d];
            v[cc] = s; }
        *(u32x4*)(dst + c8 * 8) = pack8(v); }
}

__device__ __forceinline__ void p0_ada(const Ctx& a, LAS float* lds, int tid, int lane, int wave, int bid, int G) {
    LAS float* cact = lds;
    LAS float* red = lds + 8192;
    for (int i = tid; i < NB * D_; i += 512) { const float c = a.in(1)[i]; cact[i] = c * sigmoidf_(c); }
    __syncthreads();
    float* ADA = (float*)(a.ws + WS_ADA);
    for (int it = bid; it < DEPTH * 36; it += G) {
        const int l = it / 36, col0 = (it % 36) * 256;
        const int kb = wave * 128;
        const float* w = a.in(2) + (size_t)l * D_ * 9216 + (size_t)kb * 9216 + col0 + 4 * lane;
        f32x4 acc[8];
#pragma unroll
        for (int b = 0; b < 8; ++b) acc[b] = (f32x4){0.f, 0.f, 0.f, 0.f};
#pragma unroll 2
        for (int k4 = 0; k4 < 32; ++k4) {
            f32x4 wv[4];
#pragma unroll
            for (int j = 0; j < 4; ++j) wv[j] = *(const f32x4*)(w + (size_t)(4 * k4 + j) * 9216);
#pragma unroll
            for (int b = 0; b < 8; ++b) { const f32x4 c = *(const LAS f32x4*)(cact + b * 1024 + kb + 4 * k4);
                acc[b] += c.x * wv[0] + c.y * wv[1] + c.z * wv[2] + c.w * wv[3]; }
        }
#pragma unroll
        for (int b = 0; b < 8; ++b) *(LAS f32x4*)(red + (wave * 8 + b) * 256 + 4 * lane) = acc[b];
        __syncthreads();
        { const int b = tid >> 6, c4 = (tid & 63) * 4; f32x4 s = *(const f32x4*)(a.in(3) + (size_t)l * 9216 + col0 + c4);
#pragma unroll
          for (int w2 = 0; w2 < 8; ++w2) s += *(const LAS f32x4*)(red + (w2 * 8 + b) * 256 + c4);
          *(f32x4*)(ADA + ((size_t)l * 8 + b) * 9216 + col0 + c4) = s; }
        __syncthreads();
    }
}

__device__ __forceinline__ void p0_tables(const Ctx& a, int gt, int ngt) {
    float* APOW = (float*)(a.ws + WS_APOW); float* BB = (float*)(a.ws + WS_BB);
    for (int i = gt; i < DEPTH * 16 * 64; i += ngt) {
        const int l = i >> 10, g = (i >> 6) & 15;
        const float lr = fminf(a.in(11)[i], -1e-4f), li = a.in(12)[i], dt = __expf(a.in(13)[l * 16 + g]);
        float abr = 1.f, abi = 0.f;
        for (int tau = 0; tau <= 16; ++tau) {
            const float mg = __expf((float)tau * lr * dt);
            float rev = (float)tau * li * dt * 0.15915494309189535f; rev -= floorf(rev);
            const float cr = mg * __builtin_amdgcn_cosf(rev), ci = mg * __builtin_amdgcn_sinf(rev);
            APOW[((size_t)i * 17 + tau) * 2] = cr; APOW[((size_t)i * 17 + tau) * 2 + 1] = ci;
            if (tau == 1) { abr = cr; abi = ci; }
        }
        const float den = lr * lr + li * li, nr = abr - 1.0f;
        const float fre = (nr * lr + abi * li) / den, fim = (abi * lr - nr * li) / den;
        for (int h = 0; h < 16; ++h) { const float br = a.in(14)[(size_t)i * 16 + h], bi = a.in(15)[(size_t)i * 16 + h];
            BB[((size_t)i * 16 + h) * 2] = fre * br - fim * bi; BB[((size_t)i * 16 + h) * 2 + 1] = fre * bi + fim * br; }
    }
}
__device__ __forceinline__ void p1_kern(const Ctx& a, int gt, int ngt) {
    const float* APOW = (const float*)(a.ws + WS_APOW); const float* BB = (const float*)(a.ws + WS_BB); float* KERN = (float*)(a.ws + WS_KERN);
    for (int i = gt; i < DEPTH * 16 * 16 * 256; i += ngt) {
        const int hp = i & 15, h = (i >> 4) & 15, tau = (i >> 8) & 15, lg = i >> 12;
        const float* cre = a.in(16) + ((size_t)lg * 16 + h) * 64; const float* cim = a.in(17) + ((size_t)lg * 16 + h) * 64;
        float s = 0.f;
        for (int p = 0; p < 64; ++p) {
            const float ar = APOW[(((size_t)lg * 64 + p) * 17 + tau) * 2], ai = APOW[(((size_t)lg * 64 + p) * 17 + tau) * 2 + 1];
            const float br = BB[(((size_t)lg * 64 + p) * 16 + hp) * 2], bi = BB[(((size_t)lg * 64 + p) * 16 + hp) * 2 + 1];
            const float cr = cre[p], ci = cim[p];
            const float car = cr * ar - ci * ai, cai = cr * ai + ci * ar;
            s += car * br - cai * bi;
        }
        KERN[i] = s;
    }
}
__device__ __forceinline__ void p2_fill(const Ctx& a, int gt, int ngt) {
    const float* APOW = (const float*)(a.ws + WS_APOW); const float* BB = (const float*)(a.ws + WS_BB); const float* KERN = (const float*)(a.ws + WS_KERN);
    constexpr int TMC = 16 * 256 * 48, WZC = 16 * 256 * 32;
    for (int it = gt; it < DEPTH * (TMC + WZC); it += ngt) {
        const int l = it / (TMC + WZC); int r = it % (TMC + WZC);
        unsigned char* wl = a.ws + WS_W + (size_t)l * LAYER_W;
        float v[8];
        if (r < TMC) {
            const int kc = r % 48, n = (r / 48) & 255, g = r / (48 * 256), i = n >> 4, h = n & 15, lg = l * 16 + g;
            if (kc < 32) { const int j = kc >> 1, hp0 = (kc & 1) * 8;
#pragma unroll
                for (int q = 0; q < 8; ++q) v[q] = (j <= i) ? KERN[(((size_t)lg * 16 + (i - j)) * 16 + h) * 16 + hp0 + q] : 0.f;
            } else { const int p0 = (kc - 32) * 4;
#pragma unroll
                for (int q = 0; q < 4; ++q) { const int p = p0 + q;
                    const float ar = APOW[(((size_t)lg * 64 + p) * 17 + i + 1) * 2], ai = APOW[(((size_t)lg * 64 + p) * 17 + i + 1) * 2 + 1];
                    const float cr = a.in(16)[((size_t)lg * 16 + h) * 64 + p], ci = a.in(17)[((size_t)lg * 16 + h) * 64 + p];
                    v[2 * q] = cr * ar - ci * ai; v[2 * q + 1] = -(cr * ai + ci * ar); } }
            *(u32x4*)((bf16_t*)(wl + OFF_TM) + ((size_t)g * 256 + n) * 384 + kc * 8) = pack8(v);
        } else {
            r -= TMC;
            const int kc = r & 31, n = (r >> 5) & 255, g = r >> 13, lg = l * 16 + g;
            if (n < 128) { const int p = n >> 1, part = n & 1, j = kc >> 1, hp0 = (kc & 1) * 8;
                const float ar = APOW[(((size_t)lg * 64 + p) * 17 + 15 - j) * 2], ai = APOW[(((size_t)lg * 64 + p) * 17 + 15 - j) * 2 + 1];
#pragma unroll
                for (int q = 0; q < 8; ++q) { const float br = BB[(((size_t)lg * 64 + p) * 16 + hp0 + q) * 2], bi = BB[(((size_t)lg * 64 + p) * 16 + hp0 + q) * 2 + 1];
                    v[q] = part ? (ar * bi + ai * br) : (ar * br - ai * bi); }
            } else {
#pragma unroll
                for (int q = 0; q < 8; ++q) v[q] = 0.f; }
            *(u32x4*)((bf16_t*)(wl + OFF_WZ) + ((size_t)g * 256 + n) * 256 + kc * 8) = pack8(v);
        }
    }
}

__device__ __forceinline__ void rowop(const float* xin32, const bf16_t* xinb, float* xout32, bf16_t* xoutb, const bf16_t* f, float resw, const float* ada_gate  , const float* gpost,
                                      bool do_h, const float* ada_mod  , const float* gpre, bf16_t* H, int gw, int ngw, int lane) {
    constexpr int NR = 4;
    for (int row0 = gw; row0 < T_; row0 += NR * ngw) {
        f32x4 xv[NR][4]; f32x4 fv[NR][4]; float ss[NR];
#pragma unroll
        for (int q = 0; q < NR; ++q) { const int row = (row0 + q * ngw) < T_ ? row0 + q * ngw : row0; const size_t ro = (size_t)row * D_ + 4 * lane;
#pragma unroll
            for (int j = 0; j < 4; ++j) { if (xin32) xv[q][j] = *(const f32x4*)(xin32 + ro + 256 * j);
                else { const u32x2 xw = *(const u32x2*)(xinb + ro + 256 * j); xv[q][j] = (f32x4){bf_lo(xw.x), bf_hi(xw.x), bf_lo(xw.y), bf_hi(xw.y)}; } }
            ss[q] = 0.f;
            if (f) {
#pragma unroll
                for (int j = 0; j < 4; ++j) { const u32x2 fw = *(const u32x2*)(f + ro + 256 * j); fv[q][j] = (f32x4){bf_lo(fw.x), bf_hi(fw.x), bf_lo(fw.y), bf_hi(fw.y)};
                    ss[q] += (fv[q][j].x * fv[q][j].x + fv[q][j].y * fv[q][j].y) + (fv[q][j].z * fv[q][j].z + fv[q][j].w * fv[q][j].w); } } }
#pragma unroll
        for (int q = 0; q < NR; ++q) { if ((row0 + q * ngw) >= T_) break;
            const int row = row0 + q * ngw, b = row >> 11; const size_t ro = (size_t)row * D_ + 4 * lane;
            if (f) {
                const float rs = rsqrtf(wave_sum(ss[q], lane) * (1.f / D_) + EPS_);
#pragma unroll
                for (int j = 0; j < 4; ++j) { const f32x4 gp = *(const f32x4*)(gpost + 4 * lane + 256 * j), gt = *(const f32x4*)(ada_gate + (size_t)b * 9216 + 4 * lane + 256 * j);
                    xv[q][j] = xv[q][j] + (resw * (gt + 1.0f)) * (fv[q][j] * rs * gp); }
            }
#pragma unroll
            for (int j = 0; j < 4; ++j) { if (xout32) *(f32x4*)(xout32 + ro + 256 * j) = xv[q][j];
                else { u32x2 w; w.x = cvt_pk_bf16(xv[q][j].x, xv[q][j].y); w.y = cvt_pk_bf16(xv[q][j].z, xv[q][j].w); *(u32x2*)(xoutb + ro + 256 * j) = w; } }
            if (do_h) {
                float s2 = 0.f;
#pragma unroll
                for (int j = 0; j < 4; ++j) s2 += (xv[q][j].x * xv[q][j].x + xv[q][j].y * xv[q][j].y) + (xv[q][j].z * xv[q][j].z + xv[q][j].w * xv[q][j].w);
                const float rs = rsqrtf(wave_sum(s2, lane) * (1.f / D_) + EPS_);
#pragma unroll
                for (int j = 0; j < 4; ++j) { const f32x4 gp = *(const f32x4*)(gpre + 4 * lane + 256 * j);
                    const f32x4 sh = *(const f32x4*)(ada_mod + (size_t)b * 9216 + 4 * lane + 256 * j), sc = *(const f32x4*)(ada_mod + (size_t)b * 9216 + 1024 + 4 * lane + 256 * j);
                    const f32x4 hv = (xv[q][j] * rs * gp) * (sc + 1.0f) + sh;
                    u32x2 w; w.x = cvt_pk_bf16(hv.x, hv.y); w.y = cvt_pk_bf16(hv.z, hv.w);
                    *(u32x2*)(H + ro + 256 * j) = w; }
            }
        }
    }
}

__device__ __forceinline__ void rowop_c(const float* xin32, const bf16_t* xinb, float* xout32, bf16_t* xoutb, const bf16_t* f, float resw, const float* ada_gate, const float* gpost,
                                        bool do_h, const float* ada_mod, const float* gpre, bf16_t* H, int gw, int lane) {
    constexpr int RPW = 8;
    const int rbeg = gw * RPW, b = rbeg >> 11;
    f32x4 cg[4], gpr[4], sh[4];
#pragma unroll
    for (int j = 0; j < 4; ++j) { cg[j] = (f32x4){0.f, 0.f, 0.f, 0.f}; gpr[j] = cg[j]; sh[j] = cg[j];
        if (f) { const f32x4 gpo = *(const f32x4*)(gpost + 4 * lane + 256 * j), gt = *(const f32x4*)(ada_gate + (size_t)b * 9216 + 4 * lane + 256 * j); cg[j] = (resw * (gt + 1.0f)) * gpo; }
        if (do_h) { const f32x4 gp = *(const f32x4*)(gpre + 4 * lane + 256 * j), sc = *(const f32x4*)(ada_mod + (size_t)b * 9216 + 1024 + 4 * lane + 256 * j);
            gpr[j] = gp * (sc + 1.0f); sh[j] = *(const f32x4*)(ada_mod + (size_t)b * 9216 + 4 * lane + 256 * j); } }
    for (int hh = 0; hh < 2; ++hh) {
    const int rb4 = rbeg + 4 * hh;
    u32x2 xr[4][4], fr[4][4]; f32x4 x32[4][4];
#pragma unroll
    for (int q = 0; q < 4; ++q) { const size_t ro = (size_t)(rb4 + q) * D_ + 4 * lane;
#pragma unroll
        for (int j = 0; j < 4; ++j) {
            if (xin32) x32[q][j] = *(const f32x4*)(xin32 + ro + 256 * j); else xr[q][j] = *(const u32x2*)(xinb + ro + 256 * j);
            if (f) fr[q][j] = *(const u32x2*)(f + ro + 256 * j); } }
#pragma unroll
    for (int q = 0; q < 4; ++q) { const size_t ro = (size_t)(rb4 + q) * D_ + 4 * lane;
        f32x4 xv[4]; float s2 = 0.f;
#pragma unroll
        for (int j = 0; j < 4; ++j) xv[j] = xin32 ? x32[q][j] : (f32x4){bf_lo(xr[q][j].x), bf_hi(xr[q][j].x), bf_lo(xr[q][j].y), bf_hi(xr[q][j].y)};
        if (f) { f32x4 fv[4]; float ss = 0.f;
#pragma unroll
            for (int j = 0; j < 4; ++j) { fv[j] = (f32x4){bf_lo(fr[q][j].x), bf_hi(fr[q][j].x), bf_lo(fr[q][j].y), bf_hi(fr[q][j].y)};
                ss += (fv[j].x * fv[j].x + fv[j].y * fv[j].y) + (fv[j].z * fv[j].z + fv[j].w * fv[j].w); }
            const float rs = rsqrtf(wave_sum(ss, lane) * (1.f / D_) + EPS_);
#pragma unroll
            for (int j = 0; j < 4; ++j) xv[j] = xv[j] + cg[j] * (fv[j] * rs); }
#pragma unroll
        for (int j = 0; j < 4; ++j) { s2 += (xv[j].x * xv[j].x + xv[j].y * xv[j].y) + (xv[j].z * xv[j].z + xv[j].w * xv[j].w);
            if (xout32) *(f32x4*)(xout32 + ro + 256 * j) = xv[j];
            else { u32x2 w; w.x = cvt_pk_bf16(xv[j].x, xv[j].y); w.y = cvt_pk_bf16(xv[j].z, xv[j].w); *(u32x2*)(xoutb + ro + 256 * j) = w; } }
        if (do_h) {
            const float r2 = rsqrtf(wave_sum(s2, lane) * (1.f / D_) + EPS_);
#pragma unroll
            for (int j = 0; j < 4; ++j) { const f32x4 hv = (xv[j] * r2) * gpr[j] + sh[j];
                u32x2 w; w.x = cvt_pk_bf16(hv.x, hv.y); w.y = cvt_pk_bf16(hv.z, hv.w);
                *(u32x2*)(H + ro + 256 * j) = w; }
        }
    }
    }
}

template <int W> __device__ __forceinline__ void pool_block8(const bf16_t* P, bf16_t* ACAT, int t0, int c8) {
    const int tt0 = t0 & (L_ - 1);
    u32x4 raw[W + 7];
#pragma unroll
    for (int i = 0; i < W + 7; ++i) { raw[i] = (u32x4){0u, 0u, 0u, 0u}; if (tt0 + i - (W - 1) >= 0) raw[i] = *(const u32x4*)(P + (size_t)(t0 + i - (W - 1)) * NIN + 1024 + c8); }
    float s[8];
#pragma unroll
    for (int q = 0; q < 8; ++q) s[q] = 0.f;
#pragma unroll
    for (int i = 0; i < W - 1; ++i) { float uu[8]; unpack8(raw[i], uu);
#pragma unroll
        for (int q = 0; q < 8; ++q) s[q] += uu[q]; }
#pragma unroll
    for (int j = 0; j < 8; ++j) {
        float cur[8]; unpack8(raw[W - 1 + j], cur);
#pragma unroll
        for (int q = 0; q < 8; ++q) s[q] += cur[q];
        const int cnt = (tt0 + j + 1) < W ? (tt0 + j + 1) : W; const float inv = 1.0f / (float)cnt;
        float o[8];
#pragma unroll
        for (int q = 0; q < 8; ++q) o[q] = s[q] * inv - cur[q];
        *(u32x4*)(ACAT + (size_t)(t0 + j) * D_ + 512 + c8) = pack8(o);
        float old[8]; unpack8(raw[j], old);
#pragma unroll
        for (int q = 0; q < 8; ++q) s[q] -= old[q];
    }
}
__device__ __forceinline__ void conv_block8(const bf16_t* P, bf16_t* ACAT, const float* convw, int t0, int c8) {
    const int tt0 = t0 & (L_ - 1);
    u32x4 rc[10], rv[10], rb[8];
#pragma unroll
    for (int i = 0; i < 10; ++i) { rc[i] = (u32x4){0u, 0u, 0u, 0u}; rv[i] = rc[i]; if (tt0 + i - 2 >= 0) { const size_t ro = (size_t)(t0 + i - 2) * NIN; rc[i] = *(const u32x4*)(P + ro + 256 + c8); rv[i] = *(const u32x4*)(P + ro + 512 + c8); } }
#pragma unroll
    for (int j = 0; j < 8; ++j) rb[j] = *(const u32x4*)(P + (size_t)(t0 + j) * NIN + c8);
    float w[3][8];
#pragma unroll
    for (int k = 0; k < 3; ++k) { const f32x4 w0 = *(const f32x4*)(convw + k * 256 + c8), w1 = *(const f32x4*)(convw + k * 256 + c8 + 4);
#pragma unroll
        for (int q = 0; q < 4; ++q) { w[k][q] = w0[q]; w[k][4 + q] = w1[q]; } }
    float u0[8], u1[8], u2[8];
    { float a[8], b[8]; unpack8(rc[0], a); unpack8(rv[0], b);
#pragma unroll
      for (int q = 0; q < 8; ++q) u0[q] = a[q] * b[q];
      unpack8(rc[1], a); unpack8(rv[1], b);
#pragma unroll
      for (int q = 0; q < 8; ++q) u1[q] = a[q] * b[q]; }
#pragma unroll
    for (int j = 0; j < 8; ++j) {
        float a[8], b[8], g[8], o[8]; unpack8(rc[j + 2], a); unpack8(rv[j + 2], b); unpack8(rb[j], g);
#pragma unroll
        for (int q = 0; q < 8; ++q) { u2[q] = a[q] * b[q]; o[q] = g[q] * ((w[0][q] * u0[q] + w[1][q] * u1[q]) + w[2][q] * u2[q]); u0[q] = u1[q]; u1[q] = u2[q]; }
        *(u32x4*)(ACAT + (size_t)(t0 + j) * D_ + c8) = pack8(o);
    }
}
__device__ __forceinline__ void convpool(const bf16_t* P, bf16_t* ACAT, const float* convw  , int gt, int ngt) {
    constexpr int NI = T_ * 32 / 8;
    for (int it = gt; it < 2 * NI; it += ngt) {
        if (it < NI) { conv_block8(P, ACAT, convw, (it >> 5) * 8, (it & 31) * 8); }
        else { const int p = it - NI, gi = p >> 14, rem = p & 16383, t0 = (rem >> 3) * 8, c8 = gi * 64 + (rem & 7) * 8;
            if (gi == 0) pool_block8<2>(P, ACAT, t0, c8); else if (gi == 1) pool_block8<4>(P, ACAT, t0, c8); else if (gi == 2) pool_block8<8>(P, ACAT, t0, c8); else pool_block8<16>(P, ACAT, t0, c8); }
    }
}

__device__ __forceinline__ void s5_scan_item(const float* Z, bf16_t* ASSM, const float* APOW_l, int it, int lane) {
    const int g = it >> 3, b = it & 7, p = lane;
    const float ar = APOW_l[(((size_t)g * 64 + p) * 17 + 16) * 2], ai = APOW_l[(((size_t)g * 64 + p) * 17 + 16) * 2 + 1];
    float sr = 0.f, si = 0.f;
    const size_t row0 = (size_t)g * 1024 + b * 128;
    float zr[16], zi[16], yr[16], yi[16];
#pragma unroll
    for (int c = 0; c < 16; ++c) { const float2 z = *(const float2*)(Z + (row0 + c) * 256 + 2 * p); zr[c] = z.x; zi[c] = z.y; }
    for (int c0 = 0; c0 < 128; c0 += 16) {
        if (c0 + 16 < 128) {
#pragma unroll
            for (int c = 0; c < 16; ++c) { const float2 z = *(const float2*)(Z + (row0 + c0 + 16 + c) * 256 + 2 * p); yr[c] = z.x; yi[c] = z.y; } }
#pragma unroll
        for (int c = 0; c < 16; ++c) {
            *(unsigned*)(ASSM + (row0 + c0 + c) * 384 + 256 + 2 * p) = cvt_pk_bf16(sr, si);
            const float nr = ar * sr - ai * si + zr[c], ni = ar * si + ai * sr + zi[c]; sr = nr; si = ni; }
#pragma unroll
        for (int c = 0; c < 16; ++c) { zr[c] = yr[c]; zi[c] = yi[c]; }
    }
}

__device__ __forceinline__ void sb_attn_unit(const bf16_t* P, const bf16_t* VT, bf16_t* ACAT, int b, int hd, int qb, int lane) {
    const int r32 = lane & 31, hi = lane >> 5;
    const size_t rowbase = (size_t)b * L_;
    const bf16_t* qp = P + (rowbase + 32 * qb + r32) * NIN + 1280 + hd * 64 + 8 * hi;
    bf16x8 qf[4];
#pragma unroll
    for (int d0 = 0; d0 < 4; ++d0) qf[d0] = *(const bf16x8*)(qp + 16 * d0);
    f32x16 o0, o1;
#pragma unroll
    for (int i = 0; i < 16; ++i) { o0[i] = 0.f; o1[i] = 0.f; }
    float R = 1.f;
    for (int kt = qb; kt >= 0; --kt) {
        const bf16_t* kp = P + (rowbase + 32 * kt + r32) * NIN + 1536 + hd * 64 + 8 * hi;
        bf16x8 kf[4];
#pragma unroll
        for (int d0 = 0; d0 < 4; ++d0) kf[d0] = *(const bf16x8*)(kp + 16 * d0);
        const bf16_t* vp = VT + (size_t)(hd * 64 + r32) * T_ + rowbase + 32 * kt + 4 * hi;
        s16x4 va[2][2][2];
#pragma unroll
        for (int db = 0; db < 2; ++db)
#pragma unroll
            for (int s2 = 0; s2 < 2; ++s2) { va[db][s2][0] = *(const s16x4*)(vp + (size_t)db * 32 * T_ + 16 * s2); va[db][s2][1] = *(const s16x4*)(vp + (size_t)db * 32 * T_ + 16 * s2 + 8); }
        f32x16 s;
#pragma unroll
        for (int i = 0; i < 16; ++i) s[i] = 0.f;
#pragma unroll
        for (int d0 = 0; d0 < 4; ++d0) s = __builtin_amdgcn_mfma_f32_32x32x16_bf16(kf[d0], qf[d0], s, 0, 0, 0);
        float sg[16], kq[16];
        const bool diag = (kt == qb);
#pragma unroll
        for (int i = 0; i < 16; ++i) {
            const float z = s[i];
            const float e = __expf(-fmaxf(z, -80.f));
            const float r = __builtin_amdgcn_rcpf(1.0f + e);
            const bool valid = !diag || ((8 * (i >> 2) + 4 * hi + (i & 3)) < r32);
            sg[i] = valid ? r : 0.f;
            kq[i] = valid ? e * r : 1.f;
        }
        float G[4], Gp[4];
#pragma unroll
        for (int g = 0; g < 4; ++g) { G[g] = (kq[4 * g] * kq[4 * g + 1]) * (kq[4 * g + 2] * kq[4 * g + 3]); Gp[g] = shfl_xor_(G[g], 32, lane); }
        float run = R; float aft[4];
#pragma unroll
        for (int g = 3; g >= 0; --g) { aft[g] = hi == 0 ? run * Gp[g] : run; run *= G[g] * Gp[g]; }
        float pa[16];
#pragma unroll
        for (int g = 0; g < 4; ++g) { float sfx = aft[g];
#pragma unroll
            for (int j = 3; j >= 0; --j) { pa[4 * g + j] = sg[4 * g + j] * sfx; sfx *= kq[4 * g + j]; } }
        R = run;
        bf16x8 pf[2];
#pragma unroll
        for (int s2 = 0; s2 < 2; ++s2) { u32x4 w; w.x = cvt_pk_bf16(pa[8 * s2], pa[8 * s2 + 1]); w.y = cvt_pk_bf16(pa[8 * s2 + 2], pa[8 * s2 + 3]); w.z = cvt_pk_bf16(pa[8 * s2 + 4], pa[8 * s2 + 5]); w.w = cvt_pk_bf16(pa[8 * s2 + 6], pa[8 * s2 + 7]);
            pf[s2] = __builtin_bit_cast(bf16x8, w); }
#pragma unroll
        for (int s2 = 0; s2 < 2; ++s2) {
            const bf16x8 v0 = (bf16x8){va[0][s2][0][0], va[0][s2][0][1], va[0][s2][0][2], va[0][s2][0][3], va[0][s2][1][0], va[0][s2][1][1], va[0][s2][1][2], va[0][s2][1][3]};
            const bf16x8 v1 = (bf16x8){va[1][s2][0][0], va[1][s2][0][1], va[1][s2][0][2], va[1][s2][0][3], va[1][s2][1][0], va[1][s2][1][1], va[1][s2][1][2], va[1][s2][1][3]};
            o0 = __builtin_amdgcn_mfma_f32_32x32x16_bf16(v0, pf[s2], o0, 0, 0, 0);
            o1 = __builtin_amdgcn_mfma_f32_32x32x16_bf16(v1, pf[s2], o1, 0, 0, 0);
        }
#if SB_EARLY_EXIT
        if (__all(R < 1.0e-37f)) break;
#endif
    }
    bf16_t* op = ACAT + (rowbase + 32 * qb + r32) * D_ + 768 + hd * 64 + 4 * hi;
#pragma unroll
    for (int g = 0; g < 4; ++g) {
        u32x2 w0; w0.x = cvt_pk_bf16(o0[4 * g], o0[4 * g + 1]); w0.y = cvt_pk_bf16(o0[4 * g + 2], o0[4 * g + 3]);
        u32x2 w1; w1.x = cvt_pk_bf16(o1[4 * g], o1[4 * g + 1]); w1.y = cvt_pk_bf16(o1[4 * g + 2], o1[4 * g + 3]);
        *(u32x2*)(op + 8 * g) = w0; *(u32x2*)(op + 32 + 8 * g) = w1; }
}


__device__ __forceinline__ bool bm_next(const pg8::GOrder& S, int i, int& pm, int& pnh, int& sel) {
    const int ii = i / 10, rem = i - 10 * ii, hh = rem / 5; sel = rem - 5 * hh;
    pg8::Unit u; if (!S.next(ii, u)) return false;
    pm = u.pm; pnh = 2 * u.pn + hh; return true;
}
__device__ __forceinline__ void branch_merge_phase(LAS unsigned char* lds, unsigned char* ws, const unsigned char* wl, int G, int bid, const int tid) {
    using namespace pg8;
    const int wid = __builtin_amdgcn_readfirstlane(tid >> 6), lane = tid & 63, wr = wid >> 2, wc = wid & 3, fr = lane & 15, fq = lane >> 4;
    constexpr int lda = D_, ldb = 256;
    unsigned voffA[2], voffB[2];
#pragma unroll
    for (int i = 0; i < 2; ++i) { int R, C; stage_rc(tid * 16 + i * 8192, R, C); const int Rb = (R & ~31) + perm32(R & 31);
        voffA[i] = (unsigned)(R * lda + C) * 2u; voffB[i] = (unsigned)(Rb * ldb + C) * 2u; }
    const size_t kstep = (size_t)(BK * 2), hsA = (size_t)HALF * lda * 2;
    const unsigned ldsw = (unsigned)wid * 1024u;
    const int aoff = lds_byte(wr * 64 + fr, fq * 8), boff = lds_byte(wc * 32 + fr, fq * 8);
#define BM_SA(b, h) (((b) * 2 + (h)) * HTB)
#define BM_SB(b) ((4 + (b) * 2) * HTB)
#define BM_STAGE(bufoff, gbase, voff) do { _Pragma("unroll") for (int _i = 0; _i < 2; ++_i) \
        __builtin_amdgcn_global_load_lds((const unsigned*)((const char*)(gbase) + (voff)[_i]), (LAS unsigned*)(lds + (bufoff) + ldsw + _i * 8192), 16, 0, 0); } while (0)
#define BM_LDA(dst, b, h) do { _Pragma("unroll") for (int m = 0; m < 4; ++m) _Pragma("unroll") for (int k = 0; k < 2; ++k) dst[m][k] = *(const LAS bf16x8*)(lds + BM_SA(b, h) + aoff + m * 2048 + k * 1024); } while (0)
#define BM_LDB(dst, b) do { _Pragma("unroll") for (int n = 0; n < 2; ++n) _Pragma("unroll") for (int k = 0; k < 2; ++k) dst[n][k] = *(const LAS bf16x8*)(lds + BM_SB(b) + boff + n * 2048 + k * 1024); } while (0)
#define BM_MMA(ai, At, Bt) do { __builtin_amdgcn_s_setprio(1); _Pragma("unroll") for (int m = 0; m < 4; ++m) _Pragma("unroll") for (int n = 0; n < 2; ++n) _Pragma("unroll") for (int k = 0; k < 2; ++k) \
        acc[ai][m][n] = __builtin_amdgcn_mfma_f32_16x16x32_bf16(Bt[n][k], At[m][k], acc[ai][m][n], 0, 0, 0); __builtin_amdgcn_s_setprio(0); } while (0)
#define BM_WAIT_V(n) asm volatile("s_waitcnt vmcnt(" #n ")" ::: "memory")
#define BM_WAIT_L(n) asm volatile("s_waitcnt lgkmcnt(" #n ")" ::: "memory")
#define BM_BAR __builtin_amdgcn_s_barrier()
#define BM_SCHED __builtin_amdgcn_sched_barrier(0)
#define BM_PTRS(pm_, pnh_, sel_, pa_, pb_) do { \
        pa_ = (const char*)(ws + WS_ACAT) + ((size_t)(pm_) * 256 * lda + ((sel_) == 0 ? 0 : ((sel_) == 1 ? 512 : ((sel_) == 2 ? 768 : 256)))) * 2; \
        pb_ = (const char*)wl + ((sel_) == 0 ? OFF_WCONV : ((sel_) == 1 ? OFF_WPOOL : ((sel_) == 2 ? OFF_WSB : OFF_WGLU))) \
              + (size_t)((sel_) < 3 ? (pnh_) * 128 : (pnh_) * 256 + ((sel_) == 4 ? 128 : 0)) * ldb * 2; } while (0)
    GOrder S; S.init(T_, D_, G, bid);
    int ui = 0, pm, pnh, sel, npm, npnh, nsel;
    if (!bm_next(S, 0, pm, pnh, sel)) return;
    f32x4 acc[2][4][2], macc[2][4][2]; u32x2 tmpb[2][4][2];
#pragma unroll
    for (int a = 0; a < 2; ++a)
#pragma unroll
        for (int m = 0; m < 4; ++m)
#pragma unroll
            for (int n = 0; n < 2; ++n) { acc[a][m][n] = (f32x4){0.f, 0.f, 0.f, 0.f}; macc[a][m][n] = (f32x4){0.f, 0.f, 0.f, 0.f}; tmpb[a][m][n] = (u32x2){0u, 0u}; }
    bf16x8 At[4][2], B0[2][2];
    const char* cA; const char* cB; BM_PTRS(pm, pnh, sel, cA, cB);
    BM_STAGE(BM_SB(0), cB, voffB); BM_STAGE(BM_SA(0, 0), cA, voffA); BM_STAGE(BM_SA(0, 1), cA + hsA, voffA);
    if (wr == 1) BM_BAR;
    BM_WAIT_V(2); BM_BAR;
    BM_STAGE(BM_SB(1), cB + kstep, voffB); BM_STAGE(BM_SA(1, 0), cA + kstep, voffA);
    BM_WAIT_V(4); BM_BAR;
    const bf16_t* Pg = (const bf16_t*)(ws + WS_P); bf16_t* Hm = (bf16_t*)(ws + WS_H);
    for (;;) {
        const bool has_next = bm_next(S, ui + 1, npm, npnh, nsel);
        const char* nA = cA; const char* nB = cB; if (has_next) BM_PTRS(npm, npnh, nsel, nA, nB);
#pragma unroll 1
        for (int t = 0; t < 4; t += 2) {
            const bool last = (t == 2);
            const char* a1 = cA + (size_t)(t + 1) * kstep;
            const char* a2 = last ? nA : cA + (size_t)(t + 2) * kstep; const char* b2 = last ? nB : cB + (size_t)(t + 2) * kstep;
            const char* a3 = a2 + kstep; const char* b3 = b2 + kstep;
            BM_LDB(B0, 0); BM_SCHED; BM_LDA(At, 0, 0); BM_STAGE(BM_SA(1, 1), a1 + hsA, voffA);
            BM_WAIT_V(6); BM_WAIT_L(0); BM_BAR; BM_MMA(0, At, B0); BM_BAR; BM_SCHED;
            BM_LDA(At, 0, 1); BM_STAGE(BM_SB(0), b2, voffB); BM_STAGE(BM_SA(0, 0), a2, voffA);
            BM_WAIT_V(6); BM_WAIT_L(0); BM_BAR; BM_MMA(1, At, B0); BM_BAR; BM_SCHED;
            BM_LDB(B0, 1); BM_SCHED; BM_LDA(At, 1, 0); BM_STAGE(BM_SA(0, 1), a2 + hsA, voffA);
            BM_WAIT_V(6); BM_WAIT_L(0); BM_BAR; BM_MMA(0, At, B0); BM_BAR; BM_SCHED;
            BM_LDA(At, 1, 1); BM_STAGE(BM_SB(1), b3, voffB); BM_STAGE(BM_SA(1, 0), a3, voffA);
            BM_WAIT_V(6); BM_WAIT_L(0); BM_BAR; BM_MMA(1, At, B0); BM_BAR; BM_SCHED;
        }
        if (wr == 0) BM_BAR;
        {
            const int row0 = pm * 256 + wr * 64 + fr, col = pnh * 128 + wc * 32 + 8 * fq;
            const int gcol = sel == 0 ? 2048 : (sel == 1 ? 4096 : (sel == 2 ? 5120 : 3072));
#pragma unroll
            for (int ai = 0; ai < 2; ++ai)
#pragma unroll
                for (int m = 0; m < 4; ++m) { const int r = row0 + ai * HALF + m * 16;
                    if (sel == 3) {
#pragma unroll
                        for (int n = 0; n < 2; ++n) { tmpb[ai][m][n].x = cvt_pk_bf16(acc[ai][m][n][0], acc[ai][m][n][1]); tmpb[ai][m][n].y = cvt_pk_bf16(acc[ai][m][n][2], acc[ai][m][n][3]); }
                    } else {
                        float gt[8]; unpack8(*(const u32x4*)(Pg + (size_t)r * NIN + gcol + col), gt);
#pragma unroll
                        for (int q = 0; q < 8; ++q) gt[q] = sigmoidf_(gt[q]);
#pragma unroll
                        for (int n = 0; n < 2; ++n)
#pragma unroll
                            for (int i = 0; i < 4; ++i) {
                                float y = acc[ai][m][n][i];
                                if (sel == 4) { const unsigned tw = i < 2 ? tmpb[ai][m][n].x : tmpb[ai][m][n].y; y = ((i & 1) ? bf_hi(tw) : bf_lo(tw)) * sigmoidf_(y); }
                                const float v = gt[4 * n + i] * y;
                                macc[ai][m][n][i] = sel == 0 ? v : macc[ai][m][n][i] + v; }
                        if (sel == 4) { float v[8];
#pragma unroll
                            for (int n = 0; n < 2; ++n)
#pragma unroll
                                for (int i = 0; i < 4; ++i) v[4 * n + i] = macc[ai][m][n][i];
                            *(u32x4*)(Hm + (size_t)r * D_ + col) = pack8(v); }
                    } }
        }
        if (!has_next) break;
#pragma unroll
        for (int a = 0; a < 2; ++a)
#pragma unroll
            for (int m = 0; m < 4; ++m)
#pragma unroll
                for (int n = 0; n < 2; ++n) acc[a][m][n] = (f32x4){0.f, 0.f, 0.f, 0.f};
        pm = npm; pnh = npnh; sel = nsel; cA = nA; cB = nB; ++ui;
        if (wr == 1) BM_BAR;
    }
    BM_WAIT_V(0);
    BM_BAR;
#undef BM_SA
#undef BM_SB
#undef BM_STAGE
#undef BM_LDA
#undef BM_LDB
#undef BM_MMA
#undef BM_WAIT_V
#undef BM_WAIT_L
#undef BM_BAR
#undef BM_SCHED
#undef BM_PTRS
}

__global__ void __launch_bounds__(512, 2) mega(Args args) {
    extern __shared__ __attribute__((aligned(16))) unsigned char smem[];
    LAS unsigned char* lds = (LAS unsigned char*)smem;
    const int G = gridDim.x; int bid = blockIdx.x;
    const int ngw = G * 8, ngt = G * 512;
    LAS unsigned long long* tab = (LAS unsigned long long*)(lds + 131072);
    volatile LAS unsigned* bst = (volatile LAS unsigned*)(lds + 131072 + 512);
    if (threadIdx.x == 0) { bst[0] = 0u; bst[1] = 0u; }
    __syncthreads();
    (void)xcd_barrier_post((unsigned*)(args.ws + WS_BAR), bst);
    if (threadIdx.x == 0) { const unsigned xcc = xb_xcc_id(); bst[2] = xcc; bst[3] = xb_add((unsigned*)(args.ws + WS_BAR) + XCD_BAR_WORDS + 64 * (xcc & 7u), 1u); }
    if (threadIdx.x == 0) {
#pragma unroll
        for (int i = 0; i < 25; ++i) tab[i] = (unsigned long long)args.in[i];
    }
    __syncthreads();
    Ctx a; a.tab = tab; a.ws = (unsigned char*)(GAS unsigned char*)(unsigned long long)args.ws;
    for (int ph = args.ph_lo; ph < args.ph_hi; ++ph) {
        if (args.coop && ph == args.ph_lo + 1) {
            if (threadIdx.x == 0) { unsigned* bar = (unsigned*)(args.ws + WS_BAR); bool ok = (G % 8) == 0;
                for (unsigned j = 0; j < 16; ++j) { const unsigned c = xb_ld(&bar[XB_XCNT(j)]); ok = ok && (c == (j < 8 ? (unsigned)(G / 8) : 0u)); }
                const unsigned cv = bst[3] * 8u + bst[2]; bst[4] = (ok && cv < (unsigned)G) ? cv : (unsigned)blockIdx.x; }
            __syncthreads();
            bid = (int)__builtin_amdgcn_readfirstlane(bst[4]);
        }
#define LOCAL_IDS() int tid = threadIdx.x; asm volatile("" : "+v"(tid)); const int lane = tid & 63, wave = __builtin_amdgcn_readfirstlane(tid >> 6); \
        const int gw = bid * 8 + wave, gt = bid * 512 + tid; (void)lane; (void)gw; (void)gt;
        unsigned long long wsi = (unsigned long long)args.ws; asm volatile("" : "+s"(wsi));
        unsigned char* ws = (unsigned char*)(GAS unsigned char*)wsi;
        float* X = args.out;
        float* ADA = (float*)(ws + WS_ADA);
        bf16_t* H = (bf16_t*)(ws + WS_H); bf16_t* P = (bf16_t*)(ws + WS_P); float* F = (float*)(ws + WS_F);
        bf16_t* ACAT = (bf16_t*)(ws + WS_ACAT); bf16_t* ASSM = (bf16_t*)(ws + WS_ASSM); float* Z = (float*)(ws + WS_Z); bf16_t* VT = (bf16_t*)(ws + WS_VT);
        if (ph >= 1000) {
            LOCAL_IDS();
            for (size_t i = gt; i < (size_t)T_ * D_; i += ngt) { float v = 0.f;
                if (ph == 1000) { v = bf_lo(ACAT[i]); if (!((MK_DUMP_MASK >> ((i & 1023) >> 8)) & 1)) v = 0.f; }
                else if (ph == 1001) v = F[i];
                else if (ph == 1002) v = bf_lo(H[i]);
                else if (ph == 1003) v = i < (size_t)256 * T_ ? bf_lo(VT[i]) : 0.f;
                else if (ph == 1004) { const size_t t = i >> 10, c = i & 1023; v = c < 512 ? bf_lo(P[t * NIN + 1280 + c]) : 0.f; }
                X[i] = v; }
        } else if (ph == 0) {
            LOCAL_IDS();
            p0_ada(a, (LAS float*)lds, tid, lane, wave, bid, G);
            p0_tables(a, gt, ngt);
            LAS float* scr = (LAS float*)(lds + wave * 16384);
            for (int it = gw; it < DEPTH * IT_POOL; it += ngw) p0_pool_item(a, it, lane);
            p0_transposes(a, gw, ngw, scr, lane);
        } else if (ph == 1) {
            LOCAL_IDS();
            if (T_ == 8 * ngw) rowop_c(a.in(0), nullptr, nullptr, (bf16_t*)(ws + WS_XB), nullptr, 0.f, nullptr, nullptr, true, ADA, a.in(4), H, gw, lane);
            else rowop(a.in(0), nullptr, nullptr, (bf16_t*)(ws + WS_XB), nullptr, 0.f, nullptr, nullptr, true, ADA, a.in(4), H, gw, ngw, lane);
            p1_kern(a, gt, ngt);
        } else {
            const int l = (ph - 2) / 11, st = (ph - 2) % 11;
            unsigned char* wl = ws + WS_W + (size_t)l * LAYER_W;
            const float* ada_l = ADA + (size_t)l * 8 * 9216;
            if (ph == 2) { LOCAL_IDS(); p2_fill(a, gt, ngt); }
            if (st == 2 || st == 7 || st == 10) {
                LOCAL_IDS();
                const int sub = st == 2 ? 0 : (st == 7 ? 1 : 2);
                const float resw = sub == 1 ? 1.0f : 0.5f;
                const bool last = (st == 10 && l == DEPTH - 1);
                const int nl = st == 10 ? l + 1 : l, nsub = st == 10 ? 0 : sub + 1;
                const float* ada_n = ADA + (size_t)(last ? l : nl) * 8 * 9216 + nsub * 3072;
                const float* gpre = a.in(4) + (size_t)((last ? l : nl) * 3 + nsub) * D_;
                if (T_ == 8 * ngw)
                    rowop_c(nullptr, (const bf16_t*)(ws + WS_XB), last ? X : nullptr, (bf16_t*)(ws + WS_XB), (const bf16_t*)F, resw, ada_l + sub * 3072 + 2048, a.in(5) + (size_t)(l * 3 + sub) * D_, !last, ada_n, gpre, H, gw, lane);
                else
                    rowop(nullptr, (const bf16_t*)(ws + WS_XB), last ? X : nullptr, (bf16_t*)(ws + WS_XB), (const bf16_t*)F, resw, ada_l + sub * 3072 + 2048, a.in(5) + (size_t)(l * 3 + sub) * D_, !last, ada_n, gpre, H, gw, ngw, lane);
            } else {
                if (st == 5) { int tidg = threadIdx.x; asm volatile("" : "+v"(tidg)); branch_merge_phase(lds, ws, wl, G, bid, tidg); }
                const int ng = st == 5 ? 0 : ((st == 3 || st == 4) ? 2 : 1);
                for (int gi = 0; gi < ng; ++gi) {
                    pg8::Gemm g; pg8::GOrder S; pg8::GEpi E;
                    g.bshift = 0; g.bgs = 0;
                    E.mode_ = pg8::EM_FB16; E.gcol_ = 0; E.ws = ws; E.dskip = nullptr;
                    if (st == 0 || st == 8) {
                        g.A = H; g.Bt = (const bf16_t*)(wl + OFF_FFIN0 + (st == 8 ? SZ_FFIN : 0)); g.K = D_; g.lda = D_; g.ldb = D_;
                        S.init(T_, 2 * FF_, G, bid); E.mode_ = pg8::EM_SWIGLU;
                    } else if (st == 1 || st == 9) {
                        g.A = P; g.Bt = (const bf16_t*)(wl + OFF_FFOUT0 + (st == 9 ? SZ_FFOUT : 0)); g.K = FF_; g.lda = FF_; g.ldb = FF_;
                        S.init(T_, D_, G, bid);
                    } else if (st == 3 && gi == 0) {
                        g.A = H; g.Bt = (const bf16_t*)(wl + OFF_WIN); g.K = D_; g.lda = D_; g.ldb = D_;
                        S.init(T_, NIN - 256, G, bid); S.skip = 7; E.mode_ = pg8::EM_MIXIN;
                    } else if (st == 3) {
                        g.A = (const bf16_t*)(wl + OFF_WIN) + (size_t)7 * 256 * D_; g.Bt = H; g.K = D_; g.lda = D_; g.ldb = D_;
                        const int rem = (64 * 23) % G;
                        S.init(256, T_, G, (bid - rem + G) % G); E.mode_ = pg8::EM_BF16;
                    } else if (st == 4 && gi == 0) {
                        g.A = ASSM; g.Bt = (const bf16_t*)(wl + OFF_WZ); g.K = 256; g.lda = 384; g.ldb = 256; g.bshift = 2; g.bgs = (size_t)256 * 256;
                        S.init(16384, 256, G, bid); E.mode_ = pg8::EM_F32Z;
                    } else if (st == 4) {
                        g.A = ASSM; g.Bt = (const bf16_t*)(wl + OFF_TM); g.K = 384; g.lda = 384; g.ldb = 384; g.bshift = 2; g.bgs = (size_t)256 * 384;
                        S.init(16384, 256, G, bid); E.mode_ = pg8::EM_S5Y; E.dskip = a.in(18) + (size_t)l * 256;
                    } else if (st == 5) {
                        g.A = ACAT; g.Bt = (const bf16_t*)(wl + OFF_WCONV); g.K = 256; g.lda = D_; g.ldb = 256;
                        S.init(T_, D_, G, bid); S.branch = 1; E.mode_ = pg8::EM_BRANCH;
                    } else {
                        g.A = H; g.Bt = (const bf16_t*)(wl + OFF_WOUT); g.K = D_; g.lda = D_; g.ldb = D_;
                        S.init(T_, D_, G, bid);
                    }
                    { int tidg = threadIdx.x; asm volatile("" : "+v"(tidg)); pg8::gemm_phase<pg8::GEpi, pg8::GOrder, true>(lds, g, S, E, tidg); }
                    if (st == 4 && gi == 0) {
                        LOCAL_IDS();
                        const float* APOW_l = (const float*)(ws + WS_APOW) + (size_t)l * 16 * 64 * 17 * 2;
                        pg8::Unit u;
                        for (int i = 0; S.next(i, u); ++i) { const int it = (u.pm >> 2) * 8 + 2 * (u.pm & 3) + ((wave + 2 * i) & 1); if (((wave + 2 * i) & 7) < 2) s5_scan_item(Z, ASSM, APOW_l, it, lane); }
                        asm volatile("s_waitcnt vmcnt(0)" ::: "memory");
                        __syncthreads();
                    }
                }
                if (st == 4) {
                    LOCAL_IDS();
                    const int afirst = G > 64 ? 64 : 0, nslots = (G - afirst) * 8;
                    if (bid >= afirst) convpool(P, ACAT, a.in(9) + (size_t)l * 3 * 256, (bid - afirst) * 512 + tid, (G - afirst) * 512);
                    if (G == 256) {
                        if (bid >= 64) { const int xcd = bid & 7, lw = ((bid - 64) >> 3) * 8 + wave;
                            for (int lu = lw; lu < 256; lu += 192) { const int bh = xcd * 4 + (lu >> 6), qb = 63 - (lu & 63); sb_attn_unit(P, VT, ACAT, bh >> 2, bh & 3, qb, lane); } }
                    } else if (bid >= afirst)
                        for (int u = (bid - afirst) * 8 + wave; u < NB * 4 * 64; u += nslots) { const int qb = 63 - (u & 63), bh = u >> 6; sb_attn_unit(P, VT, ACAT, bh >> 2, bh & 3, qb, lane); }
                }
            }
        }
        if (ph + 1 < args.ph_hi && args.coop) {
            if (args.coop < 0) cg::this_grid().sync();
            { XcdBarrier xb; xb.bar = (unsigned*)(args.ws + WS_BAR); xb.x = xb_xcc_id(); xb.st = bst; xcd_barrier(xb); }
        }
    }
}

extern "C" void kernel_launch(void* const* d_in, const int* in_sizes, int n_in, void* d_out, int out_size, void* d_ws, size_t ws_size, hipStream_t stream) {
    static int grid = 0;
    if (grid == 0) {
        if (n_in != 25 || out_size != T_ * D_ || ws_size < WS_END) { fprintf(stderr, "kernel_launch: unexpected shapes: n_in %d out %d ws %zu (need %zu)\n", n_in, out_size, ws_size, (size_t)WS_END); grid = -1; return; }
        int dev = 0, cus = 0, per_cu = 0;
        (void)hipGetDevice(&dev);
        (void)hipDeviceGetAttribute(&cus, hipDeviceAttributeMultiprocessorCount, dev);
        if (hipFuncSetAttribute((const void*)mega, hipFuncAttributeMaxDynamicSharedMemorySize, LDS_BYTES) != hipSuccess) { fprintf(stderr, "kernel_launch: hipFuncSetAttribute failed\n"); grid = -1; return; }
        (void)hipOccupancyMaxActiveBlocksPerMultiprocessor(&per_cu, (const void*)mega, 512, LDS_BYTES);
        if (per_cu < 1) { fprintf(stderr, "kernel_launch: occupancy query says %d blocks per CU\n", per_cu); per_cu = 1; }
        (void)hipGetLastError();
        grid = cus * per_cu;
        if (grid > 256) grid = 256;
        fprintf(stderr, "kernel_launch: grid %d (cus %d, per_cu %d), ws need %zu MiB of %zu MiB\n", grid, cus, per_cu, (size_t)(WS_END >> 20), ws_size >> 20);
    }
    if (grid < 0) return;
    Args a{};
    for (int i = 0; i < 25; ++i) a.in[i] = (const float*)d_in[i];
    a.out = (float*)d_out; a.ws = (unsigned char*)d_ws;
#if MK_PER_PHASE
    for (int ph = 0; ph < NPHASE; ++ph) { a.ph_lo = ph; a.ph_hi = ph + 1; a.coop = 0; hipLaunchKernelGGL(mega, dim3(grid), dim3(512), LDS_BYTES, stream, a); }
#ifdef MK_DUMP
    a.ph_lo = MK_DUMP; a.ph_hi = MK_DUMP + 1; a.coop = 0; hipLaunchKernelGGL(mega, dim3(grid), dim3(512), LDS_BYTES, stream, a);
#endif
#else
    (void)hipMemsetAsync((char*)d_ws + WS_BAR, 0, BAR_BYTES, stream);
    a.ph_lo = 0; a.ph_hi = NPHASE; a.coop = 1;
    void* args[] = {&a};
    hipError_t e = hipLaunchCooperativeKernel((const void*)mega, dim3(grid), dim3(512), args, LDS_BYTES, stream);
    if (e != hipSuccess) fprintf(stderr, "kernel_launch: cooperative launch failed: %s (grid %d)\n", hipGetErrorString(e), grid);
#endif
}
```

```cpp
#include <hip/hip_runtime.h>
#include <hip/hip_cooperative_groups.h>
#include <cstdio>
#include <cstdint>
namespace cg = cooperative_groups;

#ifndef MK_PER_PHASE
#define MK_PER_PHASE 0
#endif
#ifndef PROBE_SYNC2
#define PROBE_SYNC2 0
#endif
#ifndef SB_EARLY_EXIT
#define SB_EARLY_EXIT 1
#endif

#define LAS __attribute__((address_space(3)))
#define GAS __attribute__((address_space(1)))
typedef unsigned short bf16_t;
typedef short bf16x8 __attribute__((ext_vector_type(8)));
typedef short s16x4 __attribute__((ext_vector_type(4)));
typedef float f32x4 __attribute__((ext_vector_type(4)));
typedef float f32x16 __attribute__((ext_vector_type(16)));
typedef unsigned u32x4 __attribute__((ext_vector_type(4)));
typedef unsigned u32x2 __attribute__((ext_vector_type(2)));

constexpr int T_ = 16384, D_ = 1024, L_ = 2048, NB = 8, FF_ = 2816, NIN = 6144, DEPTH = 4;
constexpr float EPS_ = 1e-6f;
#ifndef MK_STOP_PH
#define MK_STOP_PH (2 + 11 * DEPTH)
#define MK_DUMP_MASK 15
#endif
constexpr int NPHASE = MK_STOP_PH;

constexpr size_t SZ_FFIN = (size_t)2 * FF_ * D_ * 2, SZ_FFOUT = (size_t)D_ * FF_ * 2, SZ_WIN = (size_t)NIN * D_ * 2;
constexpr size_t SZ_BR = (size_t)D_ * 256 * 2, SZ_GLU = (size_t)2048 * 256 * 2, SZ_WOUT = (size_t)D_ * D_ * 2;
constexpr size_t SZ_TM = (size_t)16 * 256 * 384 * 2, SZ_WZ = (size_t)16 * 256 * 256 * 2;
constexpr size_t OFF_FFIN0 = 0, OFF_FFIN1 = OFF_FFIN0 + SZ_FFIN, OFF_FFOUT0 = OFF_FFIN1 + SZ_FFIN, OFF_FFOUT1 = OFF_FFOUT0 + SZ_FFOUT;
constexpr size_t OFF_WIN = OFF_FFOUT1 + SZ_FFOUT, OFF_WCONV = OFF_WIN + SZ_WIN, OFF_WPOOL = OFF_WCONV + SZ_BR, OFF_WSB = OFF_WPOOL + SZ_BR;
constexpr size_t OFF_WGLU = OFF_WSB + SZ_BR, OFF_WOUT = OFF_WGLU + SZ_GLU, OFF_TM = OFF_WOUT + SZ_WOUT, OFF_WZ = OFF_TM + SZ_TM;
constexpr size_t LAYER_W = OFF_WZ + SZ_WZ;
constexpr size_t MiB = 1u << 20;
constexpr size_t WS_W = 0;
constexpr size_t WS_ADA = ((DEPTH * LAYER_W + MiB - 1) / MiB) * MiB;
constexpr size_t WS_APOW = WS_ADA + 2 * MiB;
constexpr size_t WS_BB = WS_APOW + 1 * MiB;
constexpr size_t WS_KERN = WS_BB + 1 * MiB;
constexpr size_t WS_H = WS_KERN + 2 * MiB;
constexpr size_t WS_P = WS_H + (size_t)T_ * D_ * 2;
constexpr size_t WS_F = WS_P + (size_t)T_ * NIN * 2;
constexpr size_t WS_ACAT = WS_F + (size_t)T_ * D_ * 4;
constexpr size_t WS_ASSM = WS_ACAT + (size_t)T_ * D_ * 2;
constexpr size_t WS_Z = WS_ASSM + (size_t)16384 * 384 * 2;
constexpr size_t WS_VT = WS_Z + (size_t)16384 * 256 * 4;
constexpr size_t WS_XB = WS_VT + (size_t)256 * T_ * 2;
constexpr size_t WS_BAR = WS_XB + (size_t)T_ * D_ * 2;
constexpr size_t BAR_BYTES = 16384;
constexpr size_t WS_END = WS_BAR + BAR_BYTES;

constexpr int LDS_BYTES = 131072 + 1024;

typedef float f32x2_t __attribute__((ext_vector_type(2))); typedef __bf16 bf16x2_t __attribute__((ext_vector_type(2)));
__device__ __forceinline__ unsigned cvt_pk_bf16(float lo, float hi) { f32x2_t v = {lo, hi}; bf16x2_t b = __builtin_convertvector(v, bf16x2_t); return __builtin_bit_cast(unsigned, b); }
__device__ __forceinline__ float bf_lo(unsigned u) { return __uint_as_float(u << 16); }
__device__ __forceinline__ float bf_hi(unsigned u) { return __uint_as_float(u & 0xffff0000u); }
__device__ __forceinline__ float sigmoidf_(float x) { return __builtin_amdgcn_rcpf(1.0f + __expf(-x)); }
__device__ __forceinline__ float shfl_xor_(float v, int m, int lane) { return __int_as_float(__builtin_amdgcn_ds_bpermute((lane ^ m) << 2, __float_as_int(v))); }
__device__ __forceinline__ float wave_sum(float v, int lane) {
#pragma unroll
    for (int o = 1; o < 64; o <<= 1) v += shfl_xor_(v, o, lane);
    return v;
}
__device__ __forceinline__ void unpack8(u32x4 w, float* o) { o[0] = bf_lo(w.x); o[1] = bf_hi(w.x); o[2] = bf_lo(w.y); o[3] = bf_hi(w.y); o[4] = bf_lo(w.z); o[5] = bf_hi(w.z); o[6] = bf_lo(w.w); o[7] = bf_hi(w.w); }
__device__ __forceinline__ u32x4 pack8(const float* v) { u32x4 w; w.x = cvt_pk_bf16(v[0], v[1]); w.y = cvt_pk_bf16(v[2], v[3]); w.z = cvt_pk_bf16(v[4], v[5]); w.w = cvt_pk_bf16(v[6], v[7]); return w; }

namespace pg8 {
constexpr int BM = 256, BK = 64, HALF = 128, HTB = HALF * BK * 2, STAGE_BYTES = 8 * HTB, NXCD = 8, WGM = 8;
__host__ __device__ __forceinline__ int lds_byte(int r, int c) { const int st = (r >> 4) * 2 + (c >> 5), rr = r & 15, cc = c & 31, ob = rr * 64 + cc * 2; return st * 1024 + (ob ^ (((ob >> 9) & 1) << 5)); }
__host__ __device__ __forceinline__ void stage_rc(int b, int& R, int& C) { const int st = b / 1024, sb = b % 1024, swz = sb ^ (((sb >> 9) & 1) << 5); R = (st >> 1) * 16 + swz / 64; C = (st & 1) * 32 + (swz % 64) / 2; }
__host__ __device__ __forceinline__ int perm32(int rho) { const int n = rho >> 4, i = rho & 15; return 8 * (i >> 2) + 4 * n + (i & 3); }

struct Unit { int pm, pn, sel; };
struct Gemm { const bf16_t* A; const bf16_t* Bt; int K, lda, ldb, bshift; size_t bgs; };

struct GOrder {
    int nM, nN, nwg, G, c, skip, pair, branch;
    __device__ void init(int M, int N, int G_, int c_) { nM = M / BM; nN = N / BM; nwg = nM * nN; G = G_; c = c_; skip = -1; pair = 0; branch = 0; }
    __device__ bool next(int i, Unit& u) const {
        const int ii = branch ? (i / 5) : (pair ? (i >> 1) : i);
        const long L = (long)ii * G + c; if (L >= nwg) return false;
        int wgid = (int)L; { const int q = nwg / NXCD, r = nwg % NXCD, xcd = wgid % NXCD, off = wgid / NXCD; wgid = (xcd < r ? xcd * (q + 1) : r * (q + 1) + (xcd - r) * q) + off; }
        const int nig = WGM * nN, gid = wgid / nig, fm = gid * WGM, gsz = (nM - fm) < WGM ? (nM - fm) : WGM;
        u.pm = fm + ((wgid % nig) % gsz); u.pn = (wgid % nig) / gsz; u.sel = 0;
        if (skip >= 0 && u.pn >= skip) u.pn++;
        if (pair) u.pn = 2 * u.pn + (i & 1);
        if (branch) { u.sel = i - 5 * ii; if (u.sel >= 3) u.pn = 2 * u.pn + (u.sel - 3); }
        return true;
    }
    __device__ __forceinline__ size_t aoff(const Unit& u) const { return branch ? (u.sel == 0 ? 0u : (u.sel == 1 ? 1024u : (u.sel == 2 ? 1536u : 512u))) : 0u; }
    __device__ __forceinline__ size_t boff(const Unit& u) const { return branch ? (size_t)(u.sel < 3 ? u.sel : 3) * SZ_BR : 0u; }
};

template <class Epi, class Sched, bool ALIGN_EPI>
__device__ __forceinline__ void gemm_phase(LAS unsigned char* lds, const Gemm g, const Sched& S, const Epi& E, const int tid) {
    const int wid = __builtin_amdgcn_readfirstlane(tid >> 6), lane = tid & 63, wr = wid >> 2, wc = wid & 3, fr = lane & 15, fq = lane >> 4;
    const int K = g.K, nt = K / BK;
    unsigned voffA[2], voffB[2];
#pragma unroll
    for (int i = 0; i < 2; ++i) { int R, C; stage_rc(tid * 16 + i * 8192, R, C); const int Rb = Epi::PERM ? ((R & ~31) + perm32(R & 31)) : R;
        voffA[i] = (unsigned)(R * g.lda + C) * 2u; voffB[i] = (unsigned)(Rb * g.ldb + C) * 2u; }
    const size_t kstep = (size_t)(BK * 2);
    const size_t hsA = (size_t)HALF * g.lda * 2, hsB = (size_t)HALF * g.ldb * 2;
    const size_t tsA = 2 * hsA, tsB = 2 * hsB;
    const unsigned ldsw = (unsigned)wid * 1024u;
    const int aoff = lds_byte(wr * 64 + fr, fq * 8), boff = lds_byte(wc * 32 + fr, fq * 8);
#define PG8_SA(b, h) (((b) * 2 + (h)) * HTB)
#define PG8_SB(b, h) ((4 + (b) * 2 + (h)) * HTB)
#define PG8_STAGE(bufoff, gbase, voff) do { _Pragma("unroll") for (int _i = 0; _i < 2; ++_i) \
        __builtin_amdgcn_global_load_lds((const unsigned*)((const char*)(gbase) + (voff)[_i]), (LAS unsigned*)(lds + (bufoff) + ldsw + _i * 8192), 16, 0, 0); } while (0)
#define PG8_LDA(dst, b, h) do { _Pragma("unroll") for (int m = 0; m < 4; ++m) _Pragma("unroll") for (int k = 0; k < 2; ++k) dst[m][k] = *(const LAS bf16x8*)(lds + PG8_SA(b, h) + aoff + m * 2048 + k * 1024); } while (0)
#define PG8_LDB(dst, b, h) do { _Pragma("unroll") for (int n = 0; n < 2; ++n) _Pragma("unroll") for (int k = 0; k < 2; ++k) dst[n][k] = *(const LAS bf16x8*)(lds + PG8_SB(b, h) + boff + n * 2048 + k * 1024); } while (0)
#define PG8_MMA(ai, bj, At, Bt) do { __builtin_amdgcn_s_setprio(1); _Pragma("unroll") for (int m = 0; m < 4; ++m) _Pragma("unroll") for (int n = 0; n < 2; ++n) _Pragma("unroll") for (int k = 0; k < 2; ++k) \
        acc[ai][bj][m][n] = __builtin_amdgcn_mfma_f32_16x16x32_bf16(Bt[n][k], At[m][k], acc[ai][bj][m][n], 0, 0, 0); __builtin_amdgcn_s_setprio(0); } while (0)
#define PG8_WAIT_V(n) asm volatile("s_waitcnt vmcnt(" #n ")" ::: "memory")
#define PG8_WAIT_L(n) asm volatile("s_waitcnt lgkmcnt(" #n ")" ::: "memory")
#define PG8_BAR __builtin_amdgcn_s_barrier()
#define PG8_SCHED __builtin_amdgcn_sched_barrier(0)
    Unit cur, nxt; int ui = 0;
    if (!S.next(0, cur)) return;
    f32x4 acc[2][2][4][2];
#pragma unroll
    for (int a = 0; a < 2; ++a)
#pragma unroll
        for (int b = 0; b < 2; ++b)
#pragma unroll
            for (int m = 0; m < 4; ++m)
#pragma unroll
                for (int n = 0; n < 2; ++n) acc[a][b][m][n] = (f32x4){0.f, 0.f, 0.f, 0.f};
    bf16x8 At[4][2], B0[2][2], B1[2][2];
    const char* cA = (const char*)g.A + (size_t)cur.pm * tsA + S.aoff(cur);
    const char* cB = (const char*)g.Bt + (size_t)cur.pn * tsB + (size_t)(cur.pm >> g.bshift) * g.bgs * 2 + S.boff(cur);
    PG8_STAGE(PG8_SB(0, 0), cB, voffB); PG8_STAGE(PG8_SB(0, 1), cB + hsB, voffB); PG8_STAGE(PG8_SA(0, 0), cA, voffA); PG8_STAGE(PG8_SA(0, 1), cA + hsA, voffA);
    if (wr == 1) PG8_BAR;
    PG8_WAIT_V(2); PG8_BAR;
    PG8_STAGE(PG8_SB(1, 0), cB + kstep, voffB); PG8_STAGE(PG8_SA(1, 0), cA + kstep, voffA); PG8_STAGE(PG8_SB(1, 1), cB + hsB + kstep, voffB);
    PG8_WAIT_V(6); PG8_BAR;
    for (;;) {
        const bool has_next = S.next(ui + 1, nxt);
        const char* nA = has_next ? (const char*)g.A + (size_t)nxt.pm * tsA + S.aoff(nxt) : cA;
        const char* nB = has_next ? (const char*)g.Bt + (size_t)nxt.pn * tsB + (size_t)(nxt.pm >> g.bshift) * g.bgs * 2 + S.boff(nxt) : cB;
        for (int t = 0; t < nt; t += 2) {
            const bool last = (t == nt - 2);
            const char* a1 = cA + (size_t)(t + 1) * kstep;
            const char* a2 = last ? nA : cA + (size_t)(t + 2) * kstep; const char* b2 = last ? nB : cB + (size_t)(t + 2) * kstep;
            const char* a3 = a2 + kstep; const char* b3 = b2 + kstep;
            PG8_LDB(B0, 0, 0); PG8_LDB(B1, 0, 1); PG8_SCHED; PG8_LDA(At, 0, 0); PG8_STAGE(PG8_SA(1, 1), a1 + hsA, voffA);
            PG8_WAIT_V(8); PG8_WAIT_L(0); PG8_BAR; PG8_MMA(0, 0, At, B0); PG8_MMA(0, 1, At, B1); PG8_BAR; PG8_SCHED;
            PG8_LDA(At, 0, 1); PG8_STAGE(PG8_SB(0, 0), b2, voffB); PG8_STAGE(PG8_SB(0, 1), b2 + hsB, voffB); PG8_STAGE(PG8_SA(0, 0), a2, voffA);
            PG8_WAIT_V(8); PG8_WAIT_L(0); PG8_BAR; PG8_MMA(1, 0, At, B0); PG8_MMA(1, 1, At, B1); PG8_BAR; PG8_SCHED;
            PG8_LDB(B0, 1, 0); PG8_LDB(B1, 1, 1); PG8_SCHED; PG8_LDA(At, 1, 0); PG8_STAGE(PG8_SA(0, 1), a2 + hsA, voffA);
            PG8_WAIT_V(8); PG8_WAIT_L(0); PG8_BAR; PG8_MMA(0, 0, At, B0); PG8_MMA(0, 1, At, B1); PG8_BAR; PG8_SCHED;
            PG8_LDA(At, 1, 1); PG8_STAGE(PG8_SB(1, 0), b3, voffB); PG8_STAGE(PG8_SB(1, 1), b3 + hsB, voffB); PG8_STAGE(PG8_SA(1, 0), a3, voffA);
            PG8_WAIT_V(8); PG8_WAIT_L(0); PG8_BAR; PG8_MMA(1, 0, At, B0); PG8_MMA(1, 1, At, B1); PG8_BAR; PG8_SCHED;
        }
        if constexpr (ALIGN_EPI) { if (wr == 0) PG8_BAR; }
        E(acc, cur, wr, wc, fr, fq);
        if (!has_next) break;
#pragma unroll
        for (int a = 0; a < 2; ++a)
#pragma unroll
            for (int b = 0; b < 2; ++b)
#pragma unroll
                for (int m = 0; m < 4; ++m)
#pragma unroll
                    for (int n = 0; n < 2; ++n) acc[a][b][m][n] = (f32x4){0.f, 0.f, 0.f, 0.f};
        cur = nxt; cA = nA; cB = nB; ++ui;
        if constexpr (ALIGN_EPI) { if (wr == 1) PG8_BAR; }
    }
    PG8_WAIT_V(0);
    if constexpr (!ALIGN_EPI) { if (wr == 0) PG8_BAR; }
    PG8_BAR;
#undef PG8_SA
#undef PG8_SB
#undef PG8_STAGE
#undef PG8_LDA
#undef PG8_LDB
#undef PG8_MMA
#undef PG8_WAIT_V
#undef PG8_WAIT_L
#undef PG8_BAR
#undef PG8_SCHED
}

typedef const f32x4 (&AccRef)[2][2][4][2];
enum { EM_FB16 = 0, EM_BF16 = 1, EM_SWIGLU = 2, EM_MIXIN = 3, EM_BR0 = 4, EM_BR1 = 5, EM_GLU = 6, EM_S5Y = 7, EM_F32Z = 8, EM_BR2 = 9, EM_BRANCH = 10 };
struct GEpi {
    static constexpr bool PERM = true;
    int mode_; int gcol_; unsigned char* ws; const float* dskip;
    __device__ __forceinline__ void operator()(AccRef acc, const Unit& u, int wr, int wc, int fr, int fq) const {
        const int mode = mode_ == EM_BRANCH ? (u.sel == 0 ? EM_BR0 : (u.sel == 1 ? EM_BR1 : (u.sel == 2 ? EM_BR2 : EM_GLU))) : mode_;
        const int gcol = mode_ == EM_BRANCH ? (u.sel == 0 ? 2048 : (u.sel == 1 ? 4096 : 5120)) : gcol_;
        float* of = (float*)(ws + WS_Z); const float* pf = dskip;
        bf16_t* ob = (bf16_t*)(ws + (mode == EM_BF16 ? WS_VT : (mode == EM_GLU || mode == EM_BR2 ? WS_H : (mode == EM_S5Y ? WS_ACAT : (mode == EM_FB16 || mode == EM_BR0 ? WS_F : (mode == EM_BR1 ? WS_F + (size_t)T_ * D_ * 2 : WS_P))))));
        bf16_t* ob2 = (bf16_t*)(ws + WS_ASSM); const bf16_t* pb = (const bf16_t*)(ws + (mode == EM_S5Y ? WS_ASSM : WS_P));
        const int ldc = mode == EM_F32Z ? 256 : (mode == EM_BF16 ? T_ : (mode == EM_SWIGLU ? FF_ : D_));
        const int row0 = u.pm * BM + wr * 64 + fr;
        if (mode == EM_F32Z) {
#pragma unroll
            for (int ai = 0; ai < 2; ++ai)
#pragma unroll
                for (int m = 0; m < 4; ++m) { float* rowp = of + (size_t)(row0 + ai * HALF + m * 16) * ldc + u.pn * BM + wc * 32 + 8 * fq;
#pragma unroll
                    for (int bj = 0; bj < 2; ++bj) { *(f32x4*)(rowp + bj * HALF) = acc[ai][bj][m][0]; *(f32x4*)(rowp + bj * HALF + 4) = acc[ai][bj][m][1]; } }
        } else if (mode == EM_BF16 || mode == EM_FB16) {
#pragma unroll
            for (int ai = 0; ai < 2; ++ai)
#pragma unroll
                for (int m = 0; m < 4; ++m) { bf16_t* rowp = ob + (size_t)(row0 + ai * HALF + m * 16) * ldc + u.pn * BM + wc * 32 + 8 * fq;
#pragma unroll
                    for (int bj = 0; bj < 2; ++bj) { const f32x4 v0 = acc[ai][bj][m][0], v1 = acc[ai][bj][m][1];
                        u32x4 w; w.x = cvt_pk_bf16(v0[0], v0[1]); w.y = cvt_pk_bf16(v0[2], v0[3]); w.z = cvt_pk_bf16(v1[0], v1[1]); w.w = cvt_pk_bf16(v1[2], v1[3]);
                        *(u32x4*)(rowp + bj * HALF) = w; } }
        } else if (mode == EM_SWIGLU) {
#pragma unroll
            for (int ai = 0; ai < 2; ++ai)
#pragma unroll
                for (int m = 0; m < 4; ++m) { bf16_t* rowp = ob + (size_t)(row0 + ai * HALF + m * 16) * ldc + u.pn * HALF + wc * 32 + 8 * fq;
                    float v[8];
#pragma unroll
                    for (int n = 0; n < 2; ++n)
#pragma unroll
                        for (int i = 0; i < 4; ++i) { const float a = acc[ai][0][m][n][i], b = acc[ai][1][m][n][i]; v[4 * n + i] = a * sigmoidf_(a) * b; }
                    *(u32x4*)rowp = pack8(v); }
        } else if (mode == EM_MIXIN) {
            const bool ssm = u.pn == 3;
#pragma unroll
            for (int ai = 0; ai < 2; ++ai)
#pragma unroll
                for (int m = 0; m < 4; ++m) { const int r = row0 + ai * HALF + m * 16;
#pragma unroll
                    for (int bj = 0; bj < 2; ++bj) { const int cl = bj * HALF + wc * 32 + 8 * fq;
                        float v[8];
#pragma unroll
                        for (int n = 0; n < 2; ++n)
#pragma unroll
                            for (int i = 0; i < 4; ++i) v[4 * n + i] = acc[ai][bj][m][n][i];
                        bf16_t* dst = ssm ? ob2 + ((size_t)((cl >> 4) * 1024 + (r >> 4))) * 384 + (r & 15) * 16 + (cl & 15)
                                          : ob + (size_t)r * NIN + u.pn * BM + cl;
                        *(u32x4*)dst = pack8(v); } }
        } else if (mode == EM_BR0 || mode == EM_BR1 || mode == EM_BR2) {
#pragma unroll
            for (int ai = 0; ai < 2; ++ai)
#pragma unroll
                for (int m = 0; m < 4; ++m) { const int r = row0 + ai * HALF + m * 16;
#pragma unroll
                    for (int bj = 0; bj < 2; ++bj) { const int col = u.pn * BM + bj * HALF + wc * 32 + 8 * fq;
                        float gt[8]; unpack8(*(const u32x4*)(pb + (size_t)r * NIN + gcol + col), gt);
                        float v[8];
#pragma unroll
                        for (int i = 0; i < 4; ++i) { v[i] = gt[i] * acc[ai][bj][m][0][i]; v[4 + i] = gt[4 + i] * acc[ai][bj][m][1][i]; }
                        *(u32x4*)(ob + (size_t)r * D_ + col) = pack8(v); } }
        } else if (mode == EM_GLU) {
            const int col = u.pn * HALF + wc * 32 + 8 * fq;
            const bf16_t* g0 = (const bf16_t*)(ws + WS_F); const bf16_t* g1 = g0 + (size_t)T_ * D_;
#pragma unroll
            for (int ai = 0; ai < 2; ++ai)
#pragma unroll
                for (int m = 0; m < 4; ++m) { const int r = row0 + ai * HALF + m * 16;
                    float gt[8], p0[8], p1[8], p2[8];
                    unpack8(*(const u32x4*)(pb + (size_t)r * NIN + 2048 + 1024 + col), gt);
                    unpack8(*(const u32x4*)(g0 + (size_t)r * D_ + col), p0); unpack8(*(const u32x4*)(g1 + (size_t)r * D_ + col), p1); unpack8(*(const u32x4*)(ob + (size_t)r * D_ + col), p2);
                    float v[8];
#pragma unroll
                    for (int n = 0; n < 2; ++n)
#pragma unroll
                        for (int i = 0; i < 4; ++i) { const float a = acc[ai][0][m][n][i], g = acc[ai][1][m][n][i];
                            v[4 * n + i] = (p0[4 * n + i] + p1[4 * n + i]) + (p2[4 * n + i] + gt[4 * n + i] * a * sigmoidf_(g)); }
                    *(u32x4*)(ob + (size_t)r * D_ + col) = pack8(v); }
        } else {
#pragma unroll
            for (int ai = 0; ai < 2; ++ai)
#pragma unroll
                for (int m = 0; m < 4; ++m) { const int r = row0 + ai * HALF + m * 16, g = r >> 10, chunk = r & 1023;
#pragma unroll
                    for (int bj = 0; bj < 2; ++bj) { const int cl = bj * HALF + wc * 32 + 8 * fq, ii = cl >> 4, h0 = cl & 15;
                        float uu[8]; unpack8(*(const u32x4*)(pb + (size_t)r * 384 + cl), uu);
                        const f32x4 d0 = *(const f32x4*)(pf + g * 16 + h0), d1 = *(const f32x4*)(pf + g * 16 + h0 + 4);
                        float v[8];
#pragma unroll
                        for (int n = 0; n < 2; ++n)
#pragma unroll
                            for (int i = 0; i < 4; ++i) { const float y = acc[ai][bj][m][n][i] + (n == 0 ? d0[i] : d1[i]) * uu[4 * n + i];
                                v[4 * n + i] = y * sigmoidf_(1.5957691216f * (y + 0.044715f * y * y * y)); }
                        *(u32x4*)(ob + (size_t)(chunk * 16 + ii) * D_ + 256 + g * 16 + h0) = pack8(v); } }
        }
    }
};
}

#define XB_TMO      128
#define XB_XCNT(j)  (256  + 64 * (j))
#define XB_XSUB(j)  (1280 + 64 * (j))
#define XB_XGEN(j)  (2304 + 64 * (j))
#define XB_TOP      3328
#define XB_TOPGEN   3392
#define XCD_BAR_WORDS 3456
#define XB_SPIN_CAP (1u << 18)

__device__ __forceinline__ unsigned xb_ld(unsigned* p)              { return __hip_atomic_load(p, __ATOMIC_RELAXED, __HIP_MEMORY_SCOPE_AGENT); }
__device__ __forceinline__ unsigned xb_add(unsigned* p, unsigned v) { return __hip_atomic_fetch_add(p, v, __ATOMIC_RELAXED, __HIP_MEMORY_SCOPE_AGENT); }
__device__ __forceinline__ unsigned xb_xcc_id() { return (unsigned)__builtin_amdgcn_s_getreg((3 << 11) | 20) & 0xFu; }
#define XB_SPIN(cond, bar) do { unsigned _sp = 0; while (cond) { __builtin_amdgcn_s_sleep(1); \
    if ((++_sp & 255u) == 0u) { if (xb_ld(&(bar)[XB_TMO])) break; if (_sp > XB_SPIN_CAP) { atomicAdd(&(bar)[XB_TMO], 1u); break; } } } } while (0)

struct XcdBarrier {
    unsigned* bar; unsigned x;
    volatile LAS unsigned* st;
};

__device__ __forceinline__ XcdBarrier xcd_barrier_post(unsigned* bar, volatile LAS unsigned* st) {
    XcdBarrier b; b.bar = bar; b.x = xb_xcc_id(); b.st = st;
    if (threadIdx.x == 0) (void)xb_add(&bar[XB_XCNT(b.x)], 1u);
    return b;
}
__device__ __forceinline__ void xcd_barrier_complete(unsigned* bar, unsigned x, unsigned& nloc, unsigned& nx) {
    const unsigned G = gridDim.x * gridDim.y * gridDim.z;
    unsigned sum, cnt, mine, sp = 0u;
    for (;;) {
        sum = 0u; cnt = 0u; mine = 0u;
#pragma unroll
        for (unsigned j = 0; j < 16; ++j) { const unsigned c = xb_ld(&bar[XB_XCNT(j)]); sum += c; cnt += (c > 0u) ? 1u : 0u; mine = (j == x) ? c : mine; }
        if (sum == G) break;
        __builtin_amdgcn_s_sleep(1);
        if ((++sp & 255u) == 0u) { if (xb_ld(&bar[XB_TMO])) break; if (sp > XB_SPIN_CAP) { atomicAdd(&bar[XB_TMO], 1u); break; } }
    }
    nloc = mine > 0u ? mine : 1u; nx = cnt > 0u ? cnt : 1u;
}

__device__ __forceinline__ void xcd_barrier(const XcdBarrier& b) {
    asm volatile("s_waitcnt vmcnt(0)" ::: "memory");
    __syncthreads();
    if (threadIdx.x == 0) {
        unsigned* bar = b.bar;
        __builtin_amdgcn_s_waitcnt(0);
        unsigned nloc = b.st[0], nx = b.st[1];
        if (nloc == 0u) { xcd_barrier_complete(bar, b.x, nloc, nx); b.st[0] = nloc; b.st[1] = nx; }
        const unsigned old = xb_add(&bar[XB_XSUB(b.x)], 1u);
        const unsigned gen = old / nloc;
        if (old + 1u == (gen + 1u) * nloc) {
            __builtin_amdgcn_fence(__ATOMIC_RELEASE, "agent");
            asm volatile("s_waitcnt vmcnt(0)" ::: "memory");
            const unsigned og = xb_add(&bar[XB_TOP], 1u);
            const unsigned tg = og / nx;
            if (og + 1u == (tg + 1u) * nx) xb_add(&bar[XB_TOPGEN], 1u);
            else XB_SPIN(xb_ld(&bar[XB_TOPGEN]) == tg, bar);
            __builtin_amdgcn_fence(__ATOMIC_ACQUIRE, "agent");
            xb_add(&bar[XB_XGEN(b.x)], 1u);
            asm volatile("s_waitcnt vmcnt(0)" ::: "memory");
        } else {
            XB_SPIN(xb_ld(&bar[XB_XGEN(b.x)]) == gen, bar);
            __builtin_amdgcn_fence(__ATOMIC_ACQUIRE, "agent");
            asm volatile("s_waitcnt vmcnt(0)" ::: "memory");
        }
    }
    __syncthreads();
}

struct Args { const float* in[25]; float* out; unsigned char* ws; int ph_lo, ph_hi, coop, pad; };
struct Ctx {
    LAS const unsigned long long* tab; unsigned char* ws;
    __device__ __forceinline__ const float* in(int i) const { const unsigned long long v = tab[i];
        const unsigned lo = __builtin_amdgcn_readfirstlane((unsigned)v), hi = __builtin_amdgcn_readfirstlane((unsigned)(v >> 32));
        return (const float*)(GAS const float*)(((unsigned long long)hi << 32) | lo); }
};

struct TItem { const float* src; bf16_t* dst; int N, K, dst_row0, k0, n0; float scale; };
constexpr int IT_FFIN = (D_ / 64) * (2 * FF_ / 32), IT_FFOUT = (FF_ / 64) * (D_ / 32), IT_WIN = (D_ / 64) * (NIN / 32);
constexpr int IT_BR = (256 / 64) * (D_ / 32), IT_GLU = (256 / 64) * (2048 / 32), IT_WOUT = (D_ / 64) * (D_ / 32), IT_POOL = 4 * 16;
constexpr int IT_TILES = 2 * IT_FFIN + 2 * IT_FFOUT + IT_WIN + 2 * IT_BR + IT_GLU + IT_WOUT;

__device__ __forceinline__ void t_decode(const Ctx& a, int it, TItem& t) {
    const int l = it / IT_TILES; int r = it % IT_TILES;
    unsigned char* wl = a.ws + WS_W + (size_t)l * LAYER_W;
    t.scale = 1.f;
    if (r < 2 * IT_FFIN) { const int s = r / IT_FFIN; r %= IT_FFIN; const int nblk = 2 * FF_ / 32, kb = r / nblk, nb = r % nblk, n0 = 32 * nb;
        const int half = n0 >= FF_, j = n0 - half * FF_;
        t.src = a.in(6) + (size_t)(l * 2 + s) * D_ * 2 * FF_; t.N = 2 * FF_; t.K = D_; t.dst = (bf16_t*)(wl + OFF_FFIN0 + s * SZ_FFIN); t.dst_row0 = 256 * (j >> 7) + 128 * half + (j & 127); t.k0 = 64 * kb; t.n0 = n0; return; }
    r -= 2 * IT_FFIN;
    if (r < 2 * IT_FFOUT) { const int s = r / IT_FFOUT; r %= IT_FFOUT; const int nblk = D_ / 32, kb = r / nblk, nb = r % nblk;
        t.src = a.in(7) + (size_t)(l * 2 + s) * FF_ * D_; t.N = D_; t.K = FF_; t.dst = (bf16_t*)(wl + OFF_FFOUT0 + s * SZ_FFOUT); t.dst_row0 = 32 * nb; t.k0 = 64 * kb; t.n0 = 32 * nb; return; }
    r -= 2 * IT_FFOUT;
    if (r < IT_WIN) { const int nblk = NIN / 32, kb = r / nblk, nb = r % nblk, n0 = 32 * nb;
        t.scale = (n0 >= 1280 && n0 < 1536) ? 0.125f : 1.f;
        t.src = a.in(8) + (size_t)l * D_ * NIN; t.N = NIN; t.K = D_; t.dst = (bf16_t*)(wl + OFF_WIN); t.dst_row0 = n0; t.k0 = 64 * kb; t.n0 = n0; return; }
    r -= IT_WIN;
    if (r < 2 * IT_BR) { const int s = r / IT_BR; r %= IT_BR; const int nblk = D_ / 32, kb = r / nblk, nb = r % nblk;
        t.src = a.in(s == 0 ? 10 : 23) + (size_t)l * 256 * D_; t.N = D_; t.K = 256; t.dst = (bf16_t*)(wl + (s == 0 ? OFF_WCONV : OFF_WSB)); t.dst_row0 = 32 * nb; t.k0 = 64 * kb; t.n0 = 32 * nb; return; }
    r -= 2 * IT_BR;
    if (r < IT_GLU) { const int nblk = 2048 / 32, kb = r / nblk, nb = r % nblk, n0 = 32 * nb; const int half = n0 >= 1024, j = n0 - half * 1024;
        t.src = a.in(19) + (size_t)l * 256 * 2048; t.N = 2048; t.K = 256; t.dst = (bf16_t*)(wl + OFF_WGLU); t.dst_row0 = 256 * (j >> 7) + 128 * half + (j & 127); t.k0 = 64 * kb; t.n0 = n0; return; }
    r -= IT_GLU;
    { const int nblk = D_ / 32, kb = r / nblk, nb = r % nblk;
        t.src = a.in(24) + (size_t)l * D_ * D_; t.N = D_; t.K = D_; t.dst = (bf16_t*)(wl + OFF_WOUT); t.dst_row0 = 32 * nb; t.k0 = 64 * kb; t.n0 = 32 * nb; }
}
__device__ __forceinline__ void t_load(const TItem& t, f32x4 (&r)[8], int lane) {
    const float* p = t.src + (size_t)(t.k0 + (lane >> 3)) * t.N + t.n0 + 4 * (lane & 7);
#pragma unroll
    for (int i = 0; i < 8; ++i) r[i] = *(const f32x4*)(p + (size_t)(8 * i) * t.N);
}
__device__ __forceinline__ void t_finish(const TItem& t, const f32x4 (&r)[8], LAS float* scr, int lane) {
    LAS float* w = scr + (lane >> 3) * 33 + 4 * (lane & 7);
#pragma unroll
    for (int i = 0; i < 8; ++i) { w[(8 * i) * 33 + 0] = r[i].x * t.scale; w[(8 * i) * 33 + 1] = r[i].y * t.scale; w[(8 * i) * 33 + 2] = r[i].z * t.scale; w[(8 * i) * 33 + 3] = r[i].w * t.scale; }
    asm volatile("s_waitcnt lgkmcnt(0)" ::: "memory");
    const int c = lane & 7;
#pragma unroll
    for (int j = 0; j < 4; ++j) { const int n = (lane >> 3) + 8 * j; const LAS float* s = scr + (8 * c) * 33 + n;
        u32x4 o; o.x = cvt_pk_bf16(s[0 * 33], s[1 * 33]); o.y = cvt_pk_bf16(s[2 * 33], s[3 * 33]); o.z = cvt_pk_bf16(s[4 * 33], s[5 * 33]); o.w = cvt_pk_bf16(s[6 * 33], s[7 * 33]);
        *(u32x4*)(t.dst + (size_t)(t.dst_row0 + n) * t.K + t.k0 + 8 * c) = o; }
    asm volatile("s_waitcnt lgkmcnt(0)" ::: "memory");
}
__device__ __forceinline__ void p0_transposes(const Ctx& a, int gw, int ngw, LAS float* scr, int lane) {
    constexpr int NT = DEPTH * IT_TILES;
    int it = gw; TItem ta, tb; f32x4 ra[8], rb[8];
    if (it < NT) { t_decode(a, it, ta); t_load(ta, ra, lane); }
    while (it < NT) {
        const int nx = it + ngw; const bool hn = nx < NT;
        if (hn) { t_decode(a, nx, tb); t_load(tb, rb, lane); }
        t_finish(ta, ra, scr, lane);
        if (hn) { ta = tb;
#pragma unroll
            for (int i = 0; i < 8; ++i) ra[i] = rb[i]; }
        it = nx;
    }
}
__device__ __forceinline__ void p0_pool_item(const Ctx& a, int it, int lane) {
    const int l = it >> 6, r = it & 63;
    unsigned char* wl = a.ws + WS_W + (size_t)l * LAYER_W;
    const int gi = r >> 4, n = (r & 15) * 64 + lane;
    const float* wp = a.in(20) + (size_t)l * 4 * 64 * 64 + (size_t)gi * 64 * 64;
    const float* ps = a.in(21) + (size_t)l * 256 + gi * 64;
    const float* wo = a.in(22) + (size_t)l * 256 * D_ + (size_t)gi * 64 * D_ + n;
    bf16_t* dst = (bf16_t*)(wl + OFF_WPOOL) + (size_t)n * 256 + gi * 64;
    float wv[64];
#pragma unroll
    for (int d = 0; d < 64; ++d) wv[d] = wo[(size_t)d * D_] * ps[d];
    for (int c8 = 0; c8 < 8; ++c8) { float v[8];
#pragma unroll
        for (int cc = 0; cc < 8; ++cc) { const float* wr_ = wp + (c8 * 8 + cc) * 64; float s = 0.f;
#pragma unroll
            for (int d = 0; d < 64; ++d) s += wr_[d] * wv[d];
            v[cc] = s; }
        *(u32x4*)(dst + c8 * 8) = pack8(v); }
}

__device__ __forceinline__ void p0_ada(const Ctx& a, LAS float* lds, int tid, int lane, int wave, int bid, int G) {
    LAS float* cact = lds;
    LAS float* red = lds + 8192;
    for (int i = tid; i < NB * D_; i += 512) { const float c = a.in(1)[i]; cact[i] = c * sigmoidf_(c); }
    __syncthreads();
    float* ADA = (float*)(a.ws + WS_ADA);
    for (int it = bid; it < DEPTH * 36; it += G) {
        const int l = it / 36, col0 = (it % 36) * 256;
        const int kb = wave * 128;
        const float* w = a.in(2) + (size_t)l * D_ * 9216 + (size_t)kb * 9216 + col0 + 4 * lane;
        f32x4 acc[8];
#pragma unroll
        for (int b = 0; b < 8; ++b) acc[b] = (f32x4){0.f, 0.f, 0.f, 0.f};
#pragma unroll 2
        for (int k4 = 0; k4 < 32; ++k4) {
            f32x4 wv[4];
#pragma unroll
            for (int j = 0; j < 4; ++j) wv[j] = *(const f32x4*)(w + (size_t)(4 * k4 + j) * 9216);
#pragma unroll
            for (int b = 0; b < 8; ++b) { const f32x4 c = *(const LAS f32x4*)(cact + b * 1024 + kb + 4 * k4);
                acc[b] += c.x * wv[0] + c.y * wv[1] + c.z * wv[2] + c.w * wv[3]; }
        }
#pragma unroll
        for (int b = 0; b < 8; ++b) *(LAS f32x4*)(red + (wave * 8 + b) * 256 + 4 * lane) = acc[b];
        __syncthreads();
        { const int b = tid >> 6, c4 = (tid & 63) * 4; f32x4 s = *(const f32x4*)(a.in(3) + (size_t)l * 9216 + col0 + c4);
#pragma unroll
          for (int w2 = 0; w2 < 8; ++w2) s += *(const LAS f32x4*)(red + (w2 * 8 + b) * 256 + c4);
          *(f32x4*)(ADA + ((size_t)l * 8 + b) * 9216 + col0 + c4) = s; }
        __syncthreads();
    }
}

__device__ __forceinline__ void p0_tables(const Ctx& a, int gt, int ngt) {
    float* APOW = (float*)(a.ws + WS_APOW); float* BB = (float*)(a.ws + WS_BB);
    for (int i = gt; i < DEPTH * 16 * 64; i += ngt) {
        const int l = i >> 10, g = (i >> 6) & 15;
        const float lr = fminf(a.in(11)[i], -1e-4f), li = a.in(12)[i], dt = __expf(a.in(13)[l * 16 + g]);
        float abr = 1.f, abi = 0.f;
        for (int tau = 0; tau <= 16; ++tau) {
            const float mg = __expf((float)tau * lr * dt);
            float rev = (float)tau * li * dt * 0.15915494309189535f; rev -= floorf(rev);
            const float cr = mg * __builtin_amdgcn_cosf(rev), ci = mg * __builtin_amdgcn_sinf(rev);
            APOW[((size_t)i * 17 + tau) * 2] = cr; APOW[((size_t)i * 17 + tau) * 2 + 1] = ci;
            if (tau == 1) { abr = cr; abi = ci; }
        }
        const float den = lr * lr + li * li, nr = abr - 1.0f;
        const float fre = (nr * lr + abi * li) / den, fim = (abi * lr - nr * li) / den;
        for (int h = 0; h < 16; ++h) { const float br = a.in(14)[(size_t)i * 16 + h], bi = a.in(15)[(size_t)i * 16 + h];
            BB[((size_t)i * 16 + h) * 2] = fre * br - fim * bi; BB[((size_t)i * 16 + h) * 2 + 1] = fre * bi + fim * br; }
    }
}
__device__ __forceinline__ void p1_kern(const Ctx& a, int gt, int ngt) {
    const float* APOW = (const float*)(a.ws + WS_APOW); const float* BB = (const float*)(a.ws + WS_BB); float* KERN = (float*)(a.ws + WS_KERN);
    for (int i = gt; i < DEPTH * 16 * 16 * 256; i += ngt) {
        const int hp = i & 15, h = (i >> 4) & 15, tau = (i >> 8) & 15, lg = i >> 12;
        const float* cre = a.in(16) + ((size_t)lg * 16 + h) * 64; const float* cim = a.in(17) + ((size_t)lg * 16 + h) * 64;
        float s = 0.f;
        for (int p = 0; p < 64; ++p) {
            const float ar = APOW[(((size_t)lg * 64 + p) * 17 + tau) * 2], ai = APOW[(((size_t)lg * 64 + p) * 17 + tau) * 2 + 1];
            const float br = BB[(((size_t)lg * 64 + p) * 16 + hp) * 2], bi = BB[(((size_t)lg * 64 + p) * 16 + hp) * 2 + 1];
            const float cr = cre[p], ci = cim[p];
            const float car = cr * ar - ci * ai, cai = cr * ai + ci * ar;
            s += car * br - cai * bi;
        }
        KERN[i] = s;
    }
}
__device__ __forceinline__ void p2_fill(const Ctx& a, int gt, int ngt) {
    const float* APOW = (const float*)(a.ws + WS_APOW); const float* BB = (const float*)(a.ws + WS_BB); const float* KERN = (const float*)(a.ws + WS_KERN);
    constexpr int TMC = 16 * 256 * 48, WZC = 16 * 256 * 32;
    for (int it = gt; it < DEPTH * (TMC + WZC); it += ngt) {
        const int l = it / (TMC + WZC); int r = it % (TMC + WZC);
        unsigned char* wl = a.ws + WS_W + (size_t)l * LAYER_W;
        float v[8];
        if (r < TMC) {
            const int kc = r % 48, n = (r / 48) & 255, g = r / (48 * 256), i = n >> 4, h = n & 15, lg = l * 16 + g;
            if (kc < 32) { const int j = kc >> 1, hp0 = (kc & 1) * 8;
#pragma unroll
                for (int q = 0; q < 8; ++q) v[q] = (j <= i) ? KERN[(((size_t)lg * 16 + (i - j)) * 16 + h) * 16 + hp0 + q] : 0.f;
            } else { const int p0 = (kc - 32) * 4;
#pragma unroll
                for (int q = 0; q < 4; ++q) { const int p = p0 + q;
                    const float ar = APOW[(((size_t)lg * 64 + p) * 17 + i + 1) * 2], ai = APOW[(((size_t)lg * 64 + p) * 17 + i + 1) * 2 + 1];
                    const float cr = a.in(16)[((size_t)lg * 16 + h) * 64 + p], ci = a.in(17)[((size_t)lg * 16 + h) * 64 + p];
                    v[2 * q] = cr * ar - ci * ai; v[2 * q + 1] = -(cr * ai + ci * ar); } }
            *(u32x4*)((bf16_t*)(wl + OFF_TM) + ((size_t)g * 256 + n) * 384 + kc * 8) = pack8(v);
        } else {
            r -= TMC;
            const int kc = r & 31, n = (r >> 5) & 255, g = r >> 13, lg = l * 16 + g;
            if (n < 128) { const int p = n >> 1, part = n & 1, j = kc >> 1, hp0 = (kc & 1) * 8;
                const float ar = APOW[(((size_t)lg * 64 + p) * 17 + 15 - j) * 2], ai = APOW[(((size_t)lg * 64 + p) * 17 + 15 - j) * 2 + 1];
#pragma unroll
                for (int q = 0; q < 8; ++q) { const float br = BB[(((size_t)lg * 64 + p) * 16 + hp0 + q) * 2], bi = BB[(((size_t)lg * 64 + p) * 16 + hp0 + q) * 2 + 1];
                    v[q] = part ? (ar * bi + ai * br) : (ar * br - ai * bi); }
            } else {
#pragma unroll
                for (int q = 0; q < 8; ++q) v[q] = 0.f; }
            *(u32x4*)((bf16_t*)(wl + OFF_WZ) + ((size_t)g * 256 + n) * 256 + kc * 8) = pack8(v);
        }
    }
}

__device__ __forceinline__ void rowop(const float* xin32, const bf16_t* xinb, float* xout32, bf16_t* xoutb, const bf16_t* f, float resw, const float* ada_gate  , const float* gpost,
                                      bool do_h, const float* ada_mod  , const float* gpre, bf16_t* H, int gw, int ngw, int lane) {
    constexpr int NR = 4;
    for (int row0 = gw; row0 < T_; row0 += NR * ngw) {
        f32x4 xv[NR][4]; f32x4 fv[NR][4]; float ss[NR];
#pragma unroll
        for (int q = 0; q < NR; ++q) { const int row = (row0 + q * ngw) < T_ ? row0 + q * ngw : row0; const size_t ro = (size_t)row * D_ + 4 * lane;
#pragma unroll
            for (int j = 0; j < 4; ++j) { if (xin32) xv[q][j] = *(const f32x4*)(xin32 + ro + 256 * j);
                else { const u32x2 xw = *(const u32x2*)(xinb + ro + 256 * j); xv[q][j] = (f32x4){bf_lo(xw.x), bf_hi(xw.x), bf_lo(xw.y), bf_hi(xw.y)}; } }
            ss[q] = 0.f;
            if (f) {
#pragma unroll
                for (int j = 0; j < 4; ++j) { const u32x2 fw = *(const u32x2*)(f + ro + 256 * j); fv[q][j] = (f32x4){bf_lo(fw.x), bf_hi(fw.x), bf_lo(fw.y), bf_hi(fw.y)};
                    ss[q] += (fv[q][j].x * fv[q][j].x + fv[q][j].y * fv[q][j].y) + (fv[q][j].z * fv[q][j].z + fv[q][j].w * fv[q][j].w); } } }
#pragma unroll
        for (int q = 0; q < NR; ++q) { if ((row0 + q * ngw) >= T_) break;
            const int row = row0 + q * ngw, b = row >> 11; const size_t ro = (size_t)row * D_ + 4 * lane;
            if (f) {
                const float rs = rsqrtf(wave_sum(ss[q], lane) * (1.f / D_) + EPS_);
#pragma unroll
                for (int j = 0; j < 4; ++j) { const f32x4 gp = *(const f32x4*)(gpost + 4 * lane + 256 * j), gt = *(const f32x4*)(ada_gate + (size_t)b * 9216 + 4 * lane + 256 * j);
                    xv[q][j] = xv[q][j] + (resw * (gt + 1.0f)) * (fv[q][j] * rs * gp); }
            }
#pragma unroll
            for (int j = 0; j < 4; ++j) { if (xout32) *(f32x4*)(xout32 + ro + 256 * j) = xv[q][j];
                else { u32x2 w; w.x = cvt_pk_bf16(xv[q][j].x, xv[q][j].y); w.y = cvt_pk_bf16(xv[q][j].z, xv[q][j].w); *(u32x2*)(xoutb + ro + 256 * j) = w; } }
            if (do_h) {
                float s2 = 0.f;
#pragma unroll
                for (int j = 0; j < 4; ++j) s2 += (xv[q][j].x * xv[q][j].x + xv[q][j].y * xv[q][j].y) + (xv[q][j].z * xv[q][j].z + xv[q][j].w * xv[q][j].w);
                const float rs = rsqrtf(wave_sum(s2, lane) * (1.f / D_) + EPS_);
#pragma unroll
                for (int j = 0; j < 4; ++j) { const f32x4 gp = *(const f32x4*)(gpre + 4 * lane + 256 * j);
                    const f32x4 sh = *(const f32x4*)(ada_mod + (size_t)b * 9216 + 4 * lane + 256 * j), sc = *(const f32x4*)(ada_mod + (size_t)b * 9216 + 1024 + 4 * lane + 256 * j);
                    const f32x4 hv = (xv[q][j] * rs * gp) * (sc + 1.0f) + sh;
                    u32x2 w; w.x = cvt_pk_bf16(hv.x, hv.y); w.y = cvt_pk_bf16(hv.z, hv.w);
                    *(u32x2*)(H + ro + 256 * j) = w; }
            }
        }
    }
}

__device__ __forceinline__ void rowop_c(const float* xin32, const bf16_t* xinb, float* xout32, bf16_t* xoutb, const bf16_t* f, float resw, const float* ada_gate, const float* gpost,
                                        bool do_h, const float* ada_mod, const float* gpre, bf16_t* H, int gw, int lane) {
    constexpr int RPW = 8;
    const int rbeg = gw * RPW, b = rbeg >> 11;
    f32x4 cg[4], gpr[4], sh[4];
#pragma unroll
    for (int j = 0; j < 4; ++j) { cg[j] = (f32x4){0.f, 0.f, 0.f, 0.f}; gpr[j] = cg[j]; sh[j] = cg[j];
        if (f) { const f32x4 gpo = *(const f32x4*)(gpost + 4 * lane + 256 * j), gt = *(const f32x4*)(ada_gate + (size_t)b * 9216 + 4 * lane + 256 * j); cg[j] = (resw * (gt + 1.0f)) * gpo; }
        if (do_h) { const f32x4 gp = *(const f32x4*)(gpre + 4 * lane + 256 * j), sc = *(const f32x4*)(ada_mod + (size_t)b * 9216 + 1024 + 4 * lane + 256 * j);
            gpr[j] = gp * (sc + 1.0f); sh[j] = *(const f32x4*)(ada_mod + (size_t)b * 9216 + 4 * lane + 256 * j); } }
    u32x2 xr[RPW][4], fr[RPW][4]; f32x4 x32[RPW][4];
#pragma unroll
    for (int q = 0; q < RPW; ++q) { const size_t ro = (size_t)(rbeg + q) * D_ + 4 * lane;
#pragma unroll
        for (int j = 0; j < 4; ++j) {
            if (xin32) x32[q][j] = *(const f32x4*)(xin32 + ro + 256 * j); else xr[q][j] = *(const u32x2*)(xinb + ro + 256 * j);
            if (f) fr[q][j] = *(const u32x2*)(f + ro + 256 * j); } }
#pragma unroll
    for (int q = 0; q < RPW; ++q) { const size_t ro = (size_t)(rbeg + q) * D_ + 4 * lane;
        f32x4 xv[4]; float s2 = 0.f;
#pragma unroll
        for (int j = 0; j < 4; ++j) xv[j] = xin32 ? x32[q][j] : (f32x4){bf_lo(xr[q][j].x), bf_hi(xr[q][j].x), bf_lo(xr[q][j].y), bf_hi(xr[q][j].y)};
        if (f) { f32x4 fv[4]; float ss = 0.f;
#pragma unroll
            for (int j = 0; j < 4; ++j) { fv[j] = (f32x4){bf_lo(fr[q][j].x), bf_hi(fr[q][j].x), bf_lo(fr[q][j].y), bf_hi(fr[q][j].y)};
                ss += (fv[j].x * fv[j].x + fv[j].y * fv[j].y) + (fv[j].z * fv[j].z + fv[j].w * fv[j].w); }
            const float rs = rsqrtf(wave_sum(ss, lane) * (1.f / D_) + EPS_);
#pragma unroll
            for (int j = 0; j < 4; ++j) xv[j] = xv[j] + cg[j] * (fv[j] * rs); }
#pragma unroll
        for (int j = 0; j < 4; ++j) { s2 += (xv[j].x * xv[j].x + xv[j].y * xv[j].y) + (xv[j].z * xv[j].z + xv[j].w * xv[j].w);
            if (xout32) *(f32x4*)(xout32 + ro + 256 * j) = xv[j];
            else { u32x2 w; w.x = cvt_pk_bf16(xv[j].x, xv[j].y); w.y = cvt_pk_bf16(xv[j].z, xv[j].w); *(u32x2*)(xoutb + ro + 256 * j) = w; } }
        if (do_h) {
            const float r2 = rsqrtf(wave_sum(s2, lane) * (1.f / D_) + EPS_);
#pragma unroll
            for (int j = 0; j < 4; ++j) { const f32x4 hv = (xv[j] * r2) * gpr[j] + sh[j];
                u32x2 w; w.x = cvt_pk_bf16(hv.x, hv.y); w.y = cvt_pk_bf16(hv.z, hv.w);
                *(u32x2*)(H + ro + 256 * j) = w; }
        }
    }
}

template <int W> __device__ __forceinline__ void pool_block8(const bf16_t* P, bf16_t* ACAT, int t0, int c8) {
    const int tt0 = t0 & (L_ - 1);
    u32x4 raw[W + 7];
#pragma unroll
    for (int i = 0; i < W + 7; ++i) { raw[i] = (u32x4){0u, 0u, 0u, 0u}; if (tt0 + i - (W - 1) >= 0) raw[i] = *(const u32x4*)(P + (size_t)(t0 + i - (W - 1)) * NIN + 1024 + c8); }
    float s[8];
#pragma unroll
    for (int q = 0; q < 8; ++q) s[q] = 0.f;
#pragma unroll
    for (int i = 0; i < W - 1; ++i) { float uu[8]; unpack8(raw[i], uu);
#pragma unroll
        for (int q = 0; q < 8; ++q) s[q] += uu[q]; }
#pragma unroll
    for (int j = 0; j < 8; ++j) {
        float cur[8]; unpack8(raw[W - 1 + j], cur);
#pragma unroll
        for (int q = 0; q < 8; ++q) s[q] += cur[q];
        const int cnt = (tt0 + j + 1) < W ? (tt0 + j + 1) : W; const float inv = 1.0f / (float)cnt;
        float o[8];
#pragma unroll
        for (int q = 0; q < 8; ++q) o[q] = s[q] * inv - cur[q];
        *(u32x4*)(ACAT + (size_t)(t0 + j) * D_ + 512 + c8) = pack8(o);
        float old[8]; unpack8(raw[j], old);
#pragma unroll
        for (int q = 0; q < 8; ++q) s[q] -= old[q];
    }
}
__device__ __forceinline__ void conv_block8(const bf16_t* P, bf16_t* ACAT, const float* convw, int t0, int c8) {
    const int tt0 = t0 & (L_ - 1);
    u32x4 rc[10], rv[10], rb[8];
#pragma unroll
    for (int i = 0; i < 10; ++i) { rc[i] = (u32x4){0u, 0u, 0u, 0u}; rv[i] = rc[i]; if (tt0 + i - 2 >= 0) { const size_t ro = (size_t)(t0 + i - 2) * NIN; rc[i] = *(const u32x4*)(P + ro + 256 + c8); rv[i] = *(const u32x4*)(P + ro + 512 + c8); } }
#pragma unroll
    for (int j = 0; j < 8; ++j) rb[j] = *(const u32x4*)(P + (size_t)(t0 + j) * NIN + c8);
    float w[3][8];
#pragma unroll
    for (int k = 0; k < 3; ++k) { const f32x4 w0 = *(const f32x4*)(convw + k * 256 + c8), w1 = *(const f32x4*)(convw + k * 256 + c8 + 4);
#pragma unroll
        for (int q = 0; q < 4; ++q) { w[k][q] = w0[q]; w[k][4 + q] = w1[q]; } }
    float u0[8], u1[8], u2[8];
    { float a[8], b[8]; unpack8(rc[0], a); unpack8(rv[0], b);
#pragma unroll
      for (int q = 0; q < 8; ++q) u0[q] = a[q] * b[q];
      unpack8(rc[1], a); unpack8(rv[1], b);
#pragma unroll
      for (int q = 0; q < 8; ++q) u1[q] = a[q] * b[q]; }
#pragma unroll
    for (int j = 0; j < 8; ++j) {
        float a[8], b[8], g[8], o[8]; unpack8(rc[j + 2], a); unpack8(rv[j + 2], b); unpack8(rb[j], g);
#pragma unroll
        for (int q = 0; q < 8; ++q) { u2[q] = a[q] * b[q]; o[q] = g[q] * ((w[0][q] * u0[q] + w[1][q] * u1[q]) + w[2][q] * u2[q]); u0[q] = u1[q]; u1[q] = u2[q]; }
        *(u32x4*)(ACAT + (size_t)(t0 + j) * D_ + c8) = pack8(o);
    }
}
__device__ __forceinline__ void convpool(const bf16_t* P, bf16_t* ACAT, const float* convw  , int gt, int ngt) {
    constexpr int NI = T_ * 32 / 8;
    for (int it = gt; it < 2 * NI; it += ngt) {
        if (it < NI) { conv_block8(P, ACAT, convw, (it >> 5) * 8, (it & 31) * 8); }
        else { const int p = it - NI, gi = p >> 14, rem = p & 16383, t0 = (rem >> 3) * 8, c8 = gi * 64 + (rem & 7) * 8;
            if (gi == 0) pool_block8<2>(P, ACAT, t0, c8); else if (gi == 1) pool_block8<4>(P, ACAT, t0, c8); else if (gi == 2) pool_block8<8>(P, ACAT, t0, c8); else pool_block8<16>(P, ACAT, t0, c8); }
    }
}

__device__ __forceinline__ void s5_scan_item(const float* Z, bf16_t* ASSM, const float* APOW_l, int it, int lane) {
    const int g = it >> 3, b = it & 7, p = lane;
    const float ar = APOW_l[(((size_t)g * 64 + p) * 17 + 16) * 2], ai = APOW_l[(((size_t)g * 64 + p) * 17 + 16) * 2 + 1];
    float sr = 0.f, si = 0.f;
    const size_t row0 = (size_t)g * 1024 + b * 128;
    float zr[16], zi[16], yr[16], yi[16];
#pragma unroll
    for (int c = 0; c < 16; ++c) { const float2 z = *(const float2*)(Z + (row0 + c) * 256 + 2 * p); zr[c] = z.x; zi[c] = z.y; }
    for (int c0 = 0; c0 < 128; c0 += 16) {
        if (c0 + 16 < 128) {
#pragma unroll
            for (int c = 0; c < 16; ++c) { const float2 z = *(const float2*)(Z + (row0 + c0 + 16 + c) * 256 + 2 * p); yr[c] = z.x; yi[c] = z.y; } }
#pragma unroll
        for (int c = 0; c < 16; ++c) {
            *(unsigned*)(ASSM + (row0 + c0 + c) * 384 + 256 + 2 * p) = cvt_pk_bf16(sr, si);
            const float nr = ar * sr - ai * si + zr[c], ni = ar * si + ai * sr + zi[c]; sr = nr; si = ni; }
#pragma unroll
        for (int c = 0; c < 16; ++c) { zr[c] = yr[c]; zi[c] = yi[c]; }
    }
}

__device__ __forceinline__ void sb_attn_unit(const bf16_t* P, const bf16_t* VT, bf16_t* ACAT, int b, int hd, int qb, int lane) {
    const int r32 = lane & 31, hi = lane >> 5;
    const size_t rowbase = (size_t)b * L_;
    const bf16_t* qp = P + (rowbase + 32 * qb + r32) * NIN + 1280 + hd * 64 + 8 * hi;
    bf16x8 qf[4];
#pragma unroll
    for (int d0 = 0; d0 < 4; ++d0) qf[d0] = *(const bf16x8*)(qp + 16 * d0);
    f32x16 o0, o1;
#pragma unroll
    for (int i = 0; i < 16; ++i) { o0[i] = 0.f; o1[i] = 0.f; }
    float R = 1.f;
    for (int kt = qb; kt >= 0; --kt) {
        const bf16_t* kp = P + (rowbase + 32 * kt + r32) * NIN + 1536 + hd * 64 + 8 * hi;
        bf16x8 kf[4];
#pragma unroll
        for (int d0 = 0; d0 < 4; ++d0) kf[d0] = *(const bf16x8*)(kp + 16 * d0);
        const bf16_t* vp = VT + (size_t)(hd * 64 + r32) * T_ + rowbase + 32 * kt + 4 * hi;
        s16x4 va[2][2][2];
#pragma unroll
        for (int db = 0; db < 2; ++db)
#pragma unroll
            for (int s2 = 0; s2 < 2; ++s2) { va[db][s2][0] = *(const s16x4*)(vp + (size_t)db * 32 * T_ + 16 * s2); va[db][s2][1] = *(const s16x4*)(vp + (size_t)db * 32 * T_ + 16 * s2 + 8); }
        f32x16 s;
#pragma unroll
        for (int i = 0; i < 16; ++i) s[i] = 0.f;
#pragma unroll
        for (int d0 = 0; d0 < 4; ++d0) s = __builtin_amdgcn_mfma_f32_32x32x16_bf16(kf[d0], qf[d0], s, 0, 0, 0);
        float sg[16], kq[16];
        const bool diag = (kt == qb);
#pragma unroll
        for (int i = 0; i < 16; ++i) {
            const float z = s[i];
            const float e = __expf(-fmaxf(z, -80.f));
            const float r = __builtin_amdgcn_rcpf(1.0f + e);
            const bool valid = !diag || ((8 * (i >> 2) + 4 * hi + (i & 3)) < r32);
            sg[i] = valid ? r : 0.f;
            kq[i] = valid ? e * r : 1.f;
        }
        float G[4], Gp[4];
#pragma unroll
        for (int g = 0; g < 4; ++g) { G[g] = (kq[4 * g] * kq[4 * g + 1]) * (kq[4 * g + 2] * kq[4 * g + 3]); Gp[g] = shfl_xor_(G[g], 32, lane); }
        float run = R; float aft[4];
#pragma unroll
        for (int g = 3; g >= 0; --g) { aft[g] = hi == 0 ? run * Gp[g] : run; run *= G[g] * Gp[g]; }
        float pa[16];
#pragma unroll
        for (int g = 0; g < 4; ++g) { float sfx = aft[g];
#pragma unroll
            for (int j = 3; j >= 0; --j) { pa[4 * g + j] = sg[4 * g + j] * sfx; sfx *= kq[4 * g + j]; } }
        R = run;
        bf16x8 pf[2];
#pragma unroll
        for (int s2 = 0; s2 < 2; ++s2) { u32x4 w; w.x = cvt_pk_bf16(pa[8 * s2], pa[8 * s2 + 1]); w.y = cvt_pk_bf16(pa[8 * s2 + 2], pa[8 * s2 + 3]); w.z = cvt_pk_bf16(pa[8 * s2 + 4], pa[8 * s2 + 5]); w.w = cvt_pk_bf16(pa[8 * s2 + 6], pa[8 * s2 + 7]);
            pf[s2] = __builtin_bit_cast(bf16x8, w); }
#pragma unroll
        for (int s2 = 0; s2 < 2; ++s2) {
            const bf16x8 v0 = (bf16x8){va[0][s2][0][0], va[0][s2][0][1], va[0][s2][0][2], va[0][s2][0][3], va[0][s2][1][0], va[0][s2][1][1], va[0][s2][1][2], va[0][s2][1][3]};
            const bf16x8 v1 = (bf16x8){va[1][s2][0][0], va[1][s2][0][1], va[1][s2][0][2], va[1][s2][0][3], va[1][s2][1][0], va[1][s2][1][1], va[1][s2][1][2], va[1][s2][1][3]};
            o0 = __builtin_amdgcn_mfma_f32_32x32x16_bf16(v0, pf[s2], o0, 0, 0, 0);
            o1 = __builtin_amdgcn_mfma_f32_32x32x16_bf16(v1, pf[s2], o1, 0, 0, 0);
        }
#if SB_EARLY_EXIT
        if (__all(R < 1.0e-37f)) break;
#endif
    }
    bf16_t* op = ACAT + (rowbase + 32 * qb + r32) * D_ + 768 + hd * 64 + 4 * hi;
#pragma unroll
    for (int g = 0; g < 4; ++g) {
        u32x2 w0; w0.x = cvt_pk_bf16(o0[4 * g], o0[4 * g + 1]); w0.y = cvt_pk_bf16(o0[4 * g + 2], o0[4 * g + 3]);
        u32x2 w1; w1.x = cvt_pk_bf16(o1[4 * g], o1[4 * g + 1]); w1.y = cvt_pk_bf16(o1[4 * g + 2], o1[4 * g + 3]);
        *(u32x2*)(op + 8 * g) = w0; *(u32x2*)(op + 32 + 8 * g) = w1; }
}


__device__ __forceinline__ bool bm_next(const pg8::GOrder& S, int i, int& pm, int& pnh, int& sel) {
    const int ii = i / 10, rem = i - 10 * ii, hh = rem / 5; sel = rem - 5 * hh;
    pg8::Unit u; if (!S.next(ii, u)) return false;
    pm = u.pm; pnh = 2 * u.pn + hh; return true;
}
__device__ __forceinline__ void branch_merge_phase(LAS unsigned char* lds, unsigned char* ws, const unsigned char* wl, int G, int bid, const int tid) {
    using namespace pg8;
    const int wid = __builtin_amdgcn_readfirstlane(tid >> 6), lane = tid & 63, wr = wid >> 2, wc = wid & 3, fr = lane & 15, fq = lane >> 4;
    constexpr int lda = D_, ldb = 256;
    unsigned voffA[2], voffB[2];
#pragma unroll
    for (int i = 0; i < 2; ++i) { int R, C; stage_rc(tid * 16 + i * 8192, R, C); const int Rb = (R & ~31) + perm32(R & 31);
        voffA[i] = (unsigned)(R * lda + C) * 2u; voffB[i] = (unsigned)(Rb * ldb + C) * 2u; }
    const size_t kstep = (size_t)(BK * 2), hsA = (size_t)HALF * lda * 2;
    const unsigned ldsw = (unsigned)wid * 1024u;
    const int aoff = lds_byte(wr * 64 + fr, fq * 8), boff = lds_byte(wc * 32 + fr, fq * 8);
#define BM_SA(b, h) (((b) * 2 + (h)) * HTB)
#define BM_SB(b) ((4 + (b) * 2) * HTB)
#define BM_STAGE(bufoff, gbase, voff) do { _Pragma("unroll") for (int _i = 0; _i < 2; ++_i) \
        __builtin_amdgcn_global_load_lds((const unsigned*)((const char*)(gbase) + (voff)[_i]), (LAS unsigned*)(lds + (bufoff) + ldsw + _i * 8192), 16, 0, 0); } while (0)
#define BM_LDA(dst, b, h) do { _Pragma("unroll") for (int m = 0; m < 4; ++m) _Pragma("unroll") for (int k = 0; k < 2; ++k) dst[m][k] = *(const LAS bf16x8*)(lds + BM_SA(b, h) + aoff + m * 2048 + k * 1024); } while (0)
#define BM_LDB(dst, b) do { _Pragma("unroll") for (int n = 0; n < 2; ++n) _Pragma("unroll") for (int k = 0; k < 2; ++k) dst[n][k] = *(const LAS bf16x8*)(lds + BM_SB(b) + boff + n * 2048 + k * 1024); } while (0)
#define BM_MMA(ai, At, Bt) do { __builtin_amdgcn_s_setprio(1); _Pragma("unroll") for (int m = 0; m < 4; ++m) _Pragma("unroll") for (int n = 0; n < 2; ++n) _Pragma("unroll") for (int k = 0; k < 2; ++k) \
        acc[ai][m][n] = __builtin_amdgcn_mfma_f32_16x16x32_bf16(Bt[n][k], At[m][k], acc[ai][m][n], 0, 0, 0); __builtin_amdgcn_s_setprio(0); } while (0)
#define BM_WAIT_V(n) asm volatile("s_waitcnt vmcnt(" #n ")" ::: "memory")
#define BM_WAIT_L(n) asm volatile("s_waitcnt lgkmcnt(" #n ")" ::: "memory")
#define BM_BAR __builtin_amdgcn_s_barrier()
#define BM_SCHED __builtin_amdgcn_sched_barrier(0)
#define BM_PTRS(pm_, pnh_, sel_, pa_, pb_) do { \
        pa_ = (const char*)(ws + WS_ACAT) + ((size_t)(pm_) * 256 * lda + ((sel_) == 0 ? 0 : ((sel_) == 1 ? 512 : ((sel_) == 2 ? 768 : 256)))) * 2; \
        pb_ = (const char*)wl + ((sel_) == 0 ? OFF_WCONV : ((sel_) == 1 ? OFF_WPOOL : ((sel_) == 2 ? OFF_WSB : OFF_WGLU))) \
              + (size_t)((sel_) < 3 ? (pnh_) * 128 : (pnh_) * 256 + ((sel_) == 4 ? 128 : 0)) * ldb * 2; } while (0)
    GOrder S; S.init(T_, D_, G, bid);
    int ui = 0, pm, pnh, sel, npm, npnh, nsel;
    if (!bm_next(S, 0, pm, pnh, sel)) return;
    f32x4 acc[2][4][2], macc[2][4][2]; u32x2 tmpb[2][4][2];
#pragma unroll
    for (int a = 0; a < 2; ++a)
#pragma unroll
        for (int m = 0; m < 4; ++m)
#pragma unroll
            for (int n = 0; n < 2; ++n) { acc[a][m][n] = (f32x4){0.f, 0.f, 0.f, 0.f}; macc[a][m][n] = (f32x4){0.f, 0.f, 0.f, 0.f}; tmpb[a][m][n] = (u32x2){0u, 0u}; }
    bf16x8 At[4][2], B0[2][2];
    const char* cA; const char* cB; BM_PTRS(pm, pnh, sel, cA, cB);
    BM_STAGE(BM_SB(0), cB, voffB); BM_STAGE(BM_SA(0, 0), cA, voffA); BM_STAGE(BM_SA(0, 1), cA + hsA, voffA);
    if (wr == 1) BM_BAR;
    BM_WAIT_V(2); BM_BAR;
    BM_STAGE(BM_SB(1), cB + kstep, voffB); BM_STAGE(BM_SA(1, 0), cA + kstep, voffA);
    BM_WAIT_V(4); BM_BAR;
    const bf16_t* Pg = (const bf16_t*)(ws + WS_P); bf16_t* Hm = (bf16_t*)(ws + WS_H);
    for (;;) {
        const bool has_next = bm_next(S, ui + 1, npm, npnh, nsel);
        const char* nA = cA; const char* nB = cB; if (has_next) BM_PTRS(npm, npnh, nsel, nA, nB);
#pragma unroll 1
        for (int t = 0; t < 4; t += 2) {
            const bool last = (t == 2);
            const char* a1 = cA + (size_t)(t + 1) * kstep;
            const char* a2 = last ? nA : cA + (size_t)(t + 2) * kstep; const char* b2 = last ? nB : cB + (size_t)(t + 2) * kstep;
            const char* a3 = a2 + kstep; const char* b3 = b2 + kstep;
            BM_LDB(B0, 0); BM_SCHED; BM_LDA(At, 0, 0); BM_STAGE(BM_SA(1, 1), a1 + hsA, voffA);
            BM_WAIT_V(6); BM_WAIT_L(0); BM_BAR; BM_MMA(0, At, B0); BM_BAR; BM_SCHED;
            BM_LDA(At, 0, 1); BM_STAGE(BM_SB(0), b2, voffB); BM_STAGE(BM_SA(0, 0), a2, voffA);
            BM_WAIT_V(6); BM_WAIT_L(0); BM_BAR; BM_MMA(1, At, B0); BM_BAR; BM_SCHED;
            BM_LDB(B0, 1); BM_SCHED; BM_LDA(At, 1, 0); BM_STAGE(BM_SA(0, 1), a2 + hsA, voffA);
            BM_WAIT_V(6); BM_WAIT_L(0); BM_BAR; BM_MMA(0, At, B0); BM_BAR; BM_SCHED;
            BM_LDA(At, 1, 1); BM_STAGE(BM_SB(1), b3, voffB); BM_STAGE(BM_SA(1, 0), a3, voffA);
            BM_WAIT_V(6); BM_WAIT_L(0); BM_BAR; BM_MMA(1, At, B0); BM_BAR; BM_SCHED;
        }
        if (wr == 0) BM_BAR;
        {
            const int row0 = pm * 256 + wr * 64 + fr, col = pnh * 128 + wc * 32 + 8 * fq;
            const int gcol = sel == 0 ? 2048 : (sel == 1 ? 4096 : (sel == 2 ? 5120 : 3072));
#pragma unroll
            for (int ai = 0; ai < 2; ++ai)
#pragma unroll
                for (int m = 0; m < 4; ++m) { const int r = row0 + ai * HALF + m * 16;
                    if (sel == 3) {
#pragma unroll
                        for (int n = 0; n < 2; ++n) { tmpb[ai][m][n].x = cvt_pk_bf16(acc[ai][m][n][0], acc[ai][m][n][1]); tmpb[ai][m][n].y = cvt_pk_bf16(acc[ai][m][n][2], acc[ai][m][n][3]); }
                    } else {
                        float gt[8]; unpack8(*(const u32x4*)(Pg + (size_t)r * NIN + gcol + col), gt);
#pragma unroll
                        for (int q = 0; q < 8; ++q) gt[q] = sigmoidf_(gt[q]);
#pragma unroll
                        for (int n = 0; n < 2; ++n)
#pragma unroll
                            for (int i = 0; i < 4; ++i) {
                                float y = acc[ai][m][n][i];
                                if (sel == 4) { const unsigned tw = i < 2 ? tmpb[ai][m][n].x : tmpb[ai][m][n].y; y = ((i & 1) ? bf_hi(tw) : bf_lo(tw)) * sigmoidf_(y); }
                                const float v = gt[4 * n + i] * y;
                                macc[ai][m][n][i] = sel == 0 ? v : macc[ai][m][n][i] + v; }
                        if (sel == 4) { float v[8];
#pragma unroll
                            for (int n = 0; n < 2; ++n)
#pragma unroll
                                for (int i = 0; i < 4; ++i) v[4 * n + i] = macc[ai][m][n][i];
                            *(u32x4*)(Hm + (size_t)r * D_ + col) = pack8(v); }
                    } }
        }
        if (!has_next) break;
#pragma unroll
        for (int a = 0; a < 2; ++a)
#pragma unroll
            for (int m = 0; m < 4; ++m)
#pragma unroll
                for (int n = 0; n < 2; ++n) acc[a][m][n] = (f32x4){0.f, 0.f, 0.f, 0.f};
        pm = npm; pnh = npnh; sel = nsel; cA = nA; cB = nB; ++ui;
        if (wr == 1) BM_BAR;
    }
    BM_WAIT_V(0);
    BM_BAR;
#undef BM_SA
#undef BM_SB
#undef BM_STAGE
#undef BM_LDA
#undef BM_LDB
#undef BM_MMA
#undef BM_WAIT_V
#undef BM_WAIT_L
#undef BM_BAR
#undef BM_SCHED
#undef BM_PTRS
}

__global__ void __launch_bounds__(512, 2) mega(Args args) {
    extern __shared__ __attribute__((aligned(16))) unsigned char smem[];
    LAS unsigned char* lds = (LAS unsigned char*)smem;
    const int G = gridDim.x; int bid = blockIdx.x;
    const int ngw = G * 8, ngt = G * 512;
    LAS unsigned long long* tab = (LAS unsigned long long*)(lds + 131072);
    volatile LAS unsigned* bst = (volatile LAS unsigned*)(lds + 131072 + 512);
    if (threadIdx.x == 0) { bst[0] = 0u; bst[1] = 0u; }
    __syncthreads();
    (void)xcd_barrier_post((unsigned*)(args.ws + WS_BAR), bst);
    if (threadIdx.x == 0) { const unsigned xcc = xb_xcc_id(); bst[2] = xcc; bst[3] = xb_add((unsigned*)(args.ws + WS_BAR) + XCD_BAR_WORDS + 64 * (xcc & 7u), 1u); }
    if (threadIdx.x == 0) {
#pragma unroll
        for (int i = 0; i < 25; ++i) tab[i] = (unsigned long long)args.in[i];
    }
    __syncthreads();
    Ctx a; a.tab = tab; a.ws = (unsigned char*)(GAS unsigned char*)(unsigned long long)args.ws;
    for (int ph = args.ph_lo; ph < args.ph_hi; ++ph) {
        if (args.coop && ph == args.ph_lo + 1) {
            if (threadIdx.x == 0) { unsigned* bar = (unsigned*)(args.ws + WS_BAR);
                unsigned nx = 0u, slot = 0u; bool ok = (G % 8) == 0; const unsigned myx = bst[2];
                for (unsigned j = 0; j < 16; ++j) { const unsigned c = xb_ld(&bar[XB_XCNT(j)]); if (c) { ++nx; if (j < myx) ++slot; ok = ok && (c == (unsigned)(G / 8)); } }
                ok = ok && nx == 8u;
                unsigned seen = 0u; for (unsigned j = 0; j < 16; ++j) { if (xb_ld(&bar[XB_XCNT(j)])) { if (seen & (1u << (j & 7u))) ok = false; seen |= 1u << (j & 7u); } }
                const unsigned cv = bst[3] * 8u + slot; bst[4] = (ok && cv < (unsigned)G) ? cv : (unsigned)blockIdx.x; }
            __syncthreads();
            bid = (int)__builtin_amdgcn_readfirstlane(bst[4]);
        }
#define LOCAL_IDS() int tid = threadIdx.x; asm volatile("" : "+v"(tid)); const int lane = tid & 63, wave = __builtin_amdgcn_readfirstlane(tid >> 6); \
        const int gw = bid * 8 + wave, gt = bid * 512 + tid; (void)lane; (void)gw; (void)gt;
        unsigned long long wsi = (unsigned long long)args.ws; asm volatile("" : "+s"(wsi));
        unsigned char* ws = (unsigned char*)(GAS unsigned char*)wsi;
        float* X = args.out;
        float* ADA = (float*)(ws + WS_ADA);
        bf16_t* H = (bf16_t*)(ws + WS_H); bf16_t* P = (bf16_t*)(ws + WS_P); float* F = (float*)(ws + WS_F);
        bf16_t* ACAT = (bf16_t*)(ws + WS_ACAT); bf16_t* ASSM = (bf16_t*)(ws + WS_ASSM); float* Z = (float*)(ws + WS_Z); bf16_t* VT = (bf16_t*)(ws + WS_VT);
        if (ph >= 1000) {
            LOCAL_IDS();
            for (size_t i = gt; i < (size_t)T_ * D_; i += ngt) { float v = 0.f;
                if (ph == 1000) { v = bf_lo(ACAT[i]); if (!((MK_DUMP_MASK >> ((i & 1023) >> 8)) & 1)) v = 0.f; }
                else if (ph == 1001) v = F[i];
                else if (ph == 1002) v = bf_lo(H[i]);
                else if (ph == 1003) v = i < (size_t)256 * T_ ? bf_lo(VT[i]) : 0.f;
                else if (ph == 1004) { const size_t t = i >> 10, c = i & 1023; v = c < 512 ? bf_lo(P[t * NIN + 1280 + c]) : 0.f; }
                X[i] = v; }
        } else if (ph == 0) {
            LOCAL_IDS();
            p0_ada(a, (LAS float*)lds, tid, lane, wave, bid, G);
            p0_tables(a, gt, ngt);
            LAS float* scr = (LAS float*)(lds + wave * 16384);
            for (int it = gw; it < DEPTH * IT_POOL; it += ngw) p0_pool_item(a, it, lane);
            p0_transposes(a, gw, ngw, scr, lane);
        } else if (ph == 1) {
            LOCAL_IDS();
            if (T_ == 8 * ngw) rowop_c(a.in(0), nullptr, nullptr, (bf16_t*)(ws + WS_XB), nullptr, 0.f, nullptr, nullptr, true, ADA, a.in(4), H, gw, lane);
            else rowop(a.in(0), nullptr, nullptr, (bf16_t*)(ws + WS_XB), nullptr, 0.f, nullptr, nullptr, true, ADA, a.in(4), H, gw, ngw, lane);
            p1_kern(a, gt, ngt);
        } else {
            const int l = (ph - 2) / 11, st = (ph - 2) % 11;
            unsigned char* wl = ws + WS_W + (size_t)l * LAYER_W;
            const float* ada_l = ADA + (size_t)l * 8 * 9216;
            if (ph == 2) { LOCAL_IDS(); p2_fill(a, gt, ngt); }
            if (st == 2 || st == 7 || st == 10) {
                LOCAL_IDS();
                const int sub = st == 2 ? 0 : (st == 7 ? 1 : 2);
                const float resw = sub == 1 ? 1.0f : 0.5f;
                const bool last = (st == 10 && l == DEPTH - 1);
                const int nl = st == 10 ? l + 1 : l, nsub = st == 10 ? 0 : sub + 1;
                const float* ada_n = ADA + (size_t)(last ? l : nl) * 8 * 9216 + nsub * 3072;
                const float* gpre = a.in(4) + (size_t)((last ? l : nl) * 3 + nsub) * D_;
                if (T_ == 8 * ngw)
                    rowop_c(nullptr, (const bf16_t*)(ws + WS_XB), last ? X : nullptr, (bf16_t*)(ws + WS_XB), (const bf16_t*)F, resw, ada_l + sub * 3072 + 2048, a.in(5) + (size_t)(l * 3 + sub) * D_, !last, ada_n, gpre, H, gw, lane);
                else
                    rowop(nullptr, (const bf16_t*)(ws + WS_XB), last ? X : nullptr, (bf16_t*)(ws + WS_XB), (const bf16_t*)F, resw, ada_l + sub * 3072 + 2048, a.in(5) + (size_t)(l * 3 + sub) * D_, !last, ada_n, gpre, H, gw, ngw, lane);
            } else {
                if (st == 5) { int tidg = threadIdx.x; asm volatile("" : "+v"(tidg)); branch_merge_phase(lds, ws, wl, G, bid, tidg); }
                const int ng = st == 5 ? 0 : ((st == 3 || st == 4) ? 2 : 1);
                for (int gi = 0; gi < ng; ++gi) {
                    pg8::Gemm g; pg8::GOrder S; pg8::GEpi E;
                    g.bshift = 0; g.bgs = 0;
                    E.mode_ = pg8::EM_FB16; E.gcol_ = 0; E.ws = ws; E.dskip = nullptr;
                    if (st == 0 || st == 8) {
                        g.A = H; g.Bt = (const bf16_t*)(wl + OFF_FFIN0 + (st == 8 ? SZ_FFIN : 0)); g.K = D_; g.lda = D_; g.ldb = D_;
                        S.init(T_, 2 * FF_, G, bid); E.mode_ = pg8::EM_SWIGLU;
                    } else if (st == 1 || st == 9) {
                        g.A = P; g.Bt = (const bf16_t*)(wl + OFF_FFOUT0 + (st == 9 ? SZ_FFOUT : 0)); g.K = FF_; g.lda = FF_; g.ldb = FF_;
                        S.init(T_, D_, G, bid);
                    } else if (st == 3 && gi == 0) {
                        g.A = H; g.Bt = (const bf16_t*)(wl + OFF_WIN); g.K = D_; g.lda = D_; g.ldb = D_;
                        S.init(T_, NIN - 256, G, bid); S.skip = 7; E.mode_ = pg8::EM_MIXIN;
                    } else if (st == 3) {
                        g.A = (const bf16_t*)(wl + OFF_WIN) + (size_t)7 * 256 * D_; g.Bt = H; g.K = D_; g.lda = D_; g.ldb = D_;
                        const int rem = (64 * 23) % G;
                        S.init(256, T_, G, (bid - rem + G) % G); E.mode_ = pg8::EM_BF16;
                    } else if (st == 4 && gi == 0) {
                        g.A = ASSM; g.Bt = (const bf16_t*)(wl + OFF_WZ); g.K = 256; g.lda = 384; g.ldb = 256; g.bshift = 2; g.bgs = (size_t)256 * 256;
                        S.init(16384, 256, G, bid); E.mode_ = pg8::EM_F32Z;
                    } else if (st == 4) {
                        g.A = ASSM; g.Bt = (const bf16_t*)(wl + OFF_TM); g.K = 384; g.lda = 384; g.ldb = 384; g.bshift = 2; g.bgs = (size_t)256 * 384;
                        S.init(16384, 256, G, bid); E.mode_ = pg8::EM_S5Y; E.dskip = a.in(18) + (size_t)l * 256;
                    } else if (st == 5) {
                        g.A = ACAT; g.Bt = (const bf16_t*)(wl + OFF_WCONV); g.K = 256; g.lda = D_; g.ldb = 256;
                        S.init(T_, D_, G, bid); S.branch = 1; E.mode_ = pg8::EM_BRANCH;
                    } else {
                        g.A = H; g.Bt = (const bf16_t*)(wl + OFF_WOUT); g.K = D_; g.lda = D_; g.ldb = D_;
                        S.init(T_, D_, G, bid);
                    }
                    { int tidg = threadIdx.x; asm volatile("" : "+v"(tidg)); pg8::gemm_phase<pg8::GEpi, pg8::GOrder, true>(lds, g, S, E, tidg); }
                    if (st == 4 && gi == 0) {
                        LOCAL_IDS();
                        const float* APOW_l = (const float*)(ws + WS_APOW) + (size_t)l * 16 * 64 * 17 * 2;
                        pg8::Unit u;
                        for (int i = 0; S.next(i, u); ++i) { const int it = (u.pm >> 2) * 8 + 2 * (u.pm & 3) + ((wave + 2 * i) & 1); if (((wave + 2 * i) & 7) < 2) s5_scan_item(Z, ASSM, APOW_l, it, lane); }
                        asm volatile("s_waitcnt vmcnt(0)" ::: "memory");
                        __syncthreads();
                    }
                }
                if (st == 4) {
                    LOCAL_IDS();
                    const int afirst = G > 64 ? 64 : 0, nslots = (G - afirst) * 8;
                    if (bid >= afirst) convpool(P, ACAT, a.in(9) + (size_t)l * 3 * 256, (bid - afirst) * 512 + tid, (G - afirst) * 512);
                    if (bid >= afirst)
                        for (int u = (bid - afirst) * 8 + wave; u < NB * 4 * 64; u += nslots) { const int qb = 63 - (u & 63), bh = u >> 6; sb_attn_unit(P, VT, ACAT, bh >> 2, bh & 3, qb, lane); }
                }
            }
        }
        if (ph + 1 < args.ph_hi && args.coop) {
            if (args.coop < 0) cg::this_grid().sync();
            { XcdBarrier xb; xb.bar = (unsigned*)(args.ws + WS_BAR); xb.x = xb_xcc_id(); xb.st = bst; xcd_barrier(xb); }
        }
    }
}

extern "C" void kernel_launch(void* const* d_in, const int* in_sizes, int n_in, void* d_out, int out_size, void* d_ws, size_t ws_size, hipStream_t stream) {
    static int grid = 0;
    if (grid == 0) {
        if (n_in != 25 || out_size != T_ * D_ || ws_size < WS_END) { fprintf(stderr, "kernel_launch: unexpected shapes: n_in %d out %d ws %zu (need %zu)\n", n_in, out_size, ws_size, (size_t)WS_END); grid = -1; return; }
        int dev = 0, cus = 0, per_cu = 0;
        (void)hipGetDevice(&dev);
        (void)hipDeviceGetAttribute(&cus, hipDeviceAttributeMultiprocessorCount, dev);
        if (hipFuncSetAttribute((const void*)mega, hipFuncAttributeMaxDynamicSharedMemorySize, LDS_BYTES) != hipSuccess) { fprintf(stderr, "kernel_launch: hipFuncSetAttribute failed\n"); grid = -1; return; }
        (void)hipOccupancyMaxActiveBlocksPerMultiprocessor(&per_cu, (const void*)mega, 512, LDS_BYTES);
        if (per_cu < 1) { fprintf(stderr, "kernel_launch: occupancy query says %d blocks per CU\n", per_cu); per_cu = 1; }
        (void)hipGetLastError();
        grid = cus * per_cu;
        if (grid > 256) grid = 256;
        fprintf(stderr, "kernel_launch: grid %d (cus %d, per_cu %d), ws need %zu MiB of %zu MiB\n", grid, cus, per_cu, (size_t)(WS_END >> 20), ws_size >> 20);
    }
    if (grid < 0) return;
    Args a{};
    for (int i = 0; i < 25; ++i) a.in[i] = (const float*)d_in[i];
    a.out = (float*)d_out; a.ws = (unsigned char*)d_ws;
#if MK_PER_PHASE
    for (int ph = 0; ph < NPHASE; ++ph) { a.ph_lo = ph; a.ph_hi = ph + 1; a.coop = 0; hipLaunchKernelGGL(mega, dim3(grid), dim3(512), LDS_BYTES, stream, a); }
#ifdef MK_DUMP
    a.ph_lo = MK_DUMP; a.ph_hi = MK_DUMP + 1; a.coop = 0; hipLaunchKernelGGL(mega, dim3(grid), dim3(512), LDS_BYTES, stream, a);
#endif
#else
    (void)hipMemsetAsync((char*)d_ws + WS_BAR, 0, BAR_BYTES, stream);
    a.ph_lo = 0; a.ph_hi = NPHASE; a.coop = 1;
    void* args[] = {&a};
    hipError_t e = hipLaunchCooperativeKernel((const void*)mega, dim3(grid), dim3(512), args, LDS_BYTES, stream);
    if (e != hipSuccess) fprintf(stderr, "kernel_launch: cooperative launch failed: %s (grid %d)\n", hipGetErrorString(e), grid);
#endif
}
```

```cpp
#include <hip/hip_runtime.h>
#include <hip/hip_cooperative_groups.h>
#include <cstdio>
#include <cstdint>
namespace cg = cooperative_groups;

#ifndef MK_PER_PHASE
#define MK_PER_PHASE 0
#endif
#ifndef PROBE_SYNC2
#define PROBE_SYNC2 0
#endif
#ifndef SB_EARLY_EXIT
#define SB_EARLY_EXIT 1
#endif

#define LAS __attribute__((address_space(3)))
#define GAS __attribute__((address_space(1)))
typedef unsigned short bf16_t;
typedef short bf16x8 __attribute__((ext_vector_type(8)));
typedef short s16x4 __attribute__((ext_vector_type(4)));
typedef float f32x4 __attribute__((ext_vector_type(4)));
typedef float f32x16 __attribute__((ext_vector_type(16)));
typedef unsigned u32x4 __attribute__((ext_vector_type(4)));
typedef unsigned u32x2 __attribute__((ext_vector_type(2)));

constexpr int T_ = 16384, D_ = 1024, L_ = 2048, NB = 8, FF_ = 2816, NIN = 6144, DEPTH = 4;
constexpr float EPS_ = 1e-6f;
#ifndef MK_STOP_PH
#define MK_STOP_PH (2 + 11 * DEPTH)
#define MK_DUMP_MASK 15
#endif
constexpr int NPHASE = MK_STOP_PH;

constexpr size_t SZ_FFIN = (size_t)2 * FF_ * D_ * 2, SZ_FFOUT = (size_t)D_ * FF_ * 2, SZ_WIN = (size_t)NIN * D_ * 2;
constexpr size_t SZ_BR = (size_t)D_ * 256 * 2, SZ_GLU = (size_t)2048 * 256 * 2, SZ_WOUT = (size_t)D_ * D_ * 2;
constexpr size_t SZ_TM = (size_t)16 * 256 * 384 * 2, SZ_WZ = (size_t)16 * 256 * 256 * 2;
constexpr size_t OFF_FFIN0 = 0, OFF_FFIN1 = OFF_FFIN0 + SZ_FFIN, OFF_FFOUT0 = OFF_FFIN1 + SZ_FFIN, OFF_FFOUT1 = OFF_FFOUT0 + SZ_FFOUT;
constexpr size_t OFF_WIN = OFF_FFOUT1 + SZ_FFOUT, OFF_WCONV = OFF_WIN + SZ_WIN, OFF_WPOOL = OFF_WCONV + SZ_BR, OFF_WSB = OFF_WPOOL + SZ_BR;
constexpr size_t OFF_WGLU = OFF_WSB + SZ_BR, OFF_WOUT = OFF_WGLU + SZ_GLU, OFF_TM = OFF_WOUT + SZ_WOUT, OFF_WZ = OFF_TM + SZ_TM;
constexpr size_t LAYER_W = OFF_WZ + SZ_WZ;
constexpr size_t MiB = 1u << 20;
constexpr size_t WS_W = 0;
constexpr size_t WS_ADA = ((DEPTH * LAYER_W + MiB - 1) / MiB) * MiB;
constexpr size_t WS_APOW = WS_ADA + 2 * MiB;
constexpr size_t WS_BB = WS_APOW + 1 * MiB;
constexpr size_t WS_KERN = WS_BB + 1 * MiB;
constexpr size_t WS_H = WS_KERN + 2 * MiB;
constexpr size_t WS_P = WS_H + (size_t)T_ * D_ * 2;
constexpr size_t WS_F = WS_P + (size_t)T_ * NIN * 2;
constexpr size_t WS_ACAT = WS_F + (size_t)T_ * D_ * 4;
constexpr size_t WS_ASSM = WS_ACAT + (size_t)T_ * D_ * 2;
constexpr size_t WS_Z = WS_ASSM + (size_t)16384 * 384 * 2;
constexpr size_t WS_VT = WS_Z + (size_t)16384 * 256 * 4;
constexpr size_t WS_XB = WS_VT + (size_t)256 * T_ * 2;
constexpr size_t WS_BAR = WS_XB + (size_t)T_ * D_ * 2;
constexpr size_t BAR_BYTES = 16384;
constexpr size_t WS_END = WS_BAR + BAR_BYTES;

constexpr int LDS_BYTES = 131072 + 1024;

typedef float f32x2_t __attribute__((ext_vector_type(2))); typedef __bf16 bf16x2_t __attribute__((ext_vector_type(2)));
__device__ __forceinline__ unsigned cvt_pk_bf16(float lo, float hi) { f32x2_t v = {lo, hi}; bf16x2_t b = __builtin_convertvector(v, bf16x2_t); return __builtin_bit_cast(unsigned, b); }
__device__ __forceinline__ float bf_lo(unsigned u) { return __uint_as_float(u << 16); }
__device__ __forceinline__ float bf_hi(unsigned u) { return __uint_as_float(u & 0xffff0000u); }
__device__ __forceinline__ float sigmoidf_(float x) { return __builtin_amdgcn_rcpf(1.0f + __expf(-x)); }
__device__ __forceinline__ float shfl_xor_(float v, int m, int lane) { return __int_as_float(__builtin_amdgcn_ds_bpermute((lane ^ m) << 2, __float_as_int(v))); }
__device__ __forceinline__ float wave_sum(float v, int lane) {
#pragma unroll
    for (int o = 1; o < 64; o <<= 1) v += shfl_xor_(v, o, lane);
    return v;
}
__device__ __forceinline__ void unpack8(u32x4 w, float* o) { o[0] = bf_lo(w.x); o[1] = bf_hi(w.x); o[2] = bf_lo(w.y); o[3] = bf_hi(w.y); o[4] = bf_lo(w.z); o[5] = bf_hi(w.z); o[6] = bf_lo(w.w); o[7] = bf_hi(w.w); }
__device__ __forceinline__ u32x4 pack8(const float* v) { u32x4 w; w.x = cvt_pk_bf16(v[0], v[1]); w.y = cvt_pk_bf16(v[2], v[3]); w.z = cvt_pk_bf16(v[4], v[5]); w.w = cvt_pk_bf16(v[6], v[7]); return w; }

namespace pg8 {
constexpr int BM = 256, BK = 64, HALF = 128, HTB = HALF * BK * 2, STAGE_BYTES = 8 * HTB, NXCD = 8, WGM = 8;
__host__ __device__ __forceinline__ int lds_byte(int r, int c) { const int st = (r >> 4) * 2 + (c >> 5), rr = r & 15, cc = c & 31, ob = rr * 64 + cc * 2; return st * 1024 + (ob ^ (((ob >> 9) & 1) << 5)); }
__host__ __device__ __forceinline__ void stage_rc(int b, int& R, int& C) { const int st = b / 1024, sb = b % 1024, swz = sb ^ (((sb >> 9) & 1) << 5); R = (st >> 1) * 16 + swz / 64; C = (st & 1) * 32 + (swz % 64) / 2; }
__host__ __device__ __forceinline__ int perm32(int rho) { const int n = rho >> 4, i = rho & 15; return 8 * (i >> 2) + 4 * n + (i & 3); }

struct Unit { int pm, pn, sel; };
struct Gemm { const bf16_t* A; const bf16_t* Bt; int K, lda, ldb, bshift; size_t bgs; };

struct GOrder {
    int nM, nN, nwg, G, c, skip, pair, branch;
    __device__ void init(int M, int N, int G_, int c_) { nM = M / BM; nN = N / BM; nwg = nM * nN; G = G_; c = c_; skip = -1; pair = 0; branch = 0; }
    __device__ bool next(int i, Unit& u) const {
        const int ii = branch ? (i / 5) : (pair ? (i >> 1) : i);
        const long L = (long)ii * G + c; if (L >= nwg) return false;
        int wgid = (int)L; { const int q = nwg / NXCD, r = nwg % NXCD, xcd = wgid % NXCD, off = wgid / NXCD; wgid = (xcd < r ? xcd * (q + 1) : r * (q + 1) + (xcd - r) * q) + off; }
        const int nig = WGM * nN, gid = wgid / nig, fm = gid * WGM, gsz = (nM - fm) < WGM ? (nM - fm) : WGM;
        u.pm = fm + ((wgid % nig) % gsz); u.pn = (wgid % nig) / gsz; u.sel = 0;
        if (skip >= 0 && u.pn >= skip) u.pn++;
        if (pair) u.pn = 2 * u.pn + (i & 1);
        if (branch) { u.sel = i - 5 * ii; if (u.sel >= 3) u.pn = 2 * u.pn + (u.sel - 3); }
        return true;
    }
    __device__ __forceinline__ size_t aoff(const Unit& u) const { return branch ? (u.sel == 0 ? 0u : (u.sel == 1 ? 1024u : (u.sel == 2 ? 1536u : 512u))) : 0u; }
    __device__ __forceinline__ size_t boff(const Unit& u) const { return branch ? (size_t)(u.sel < 3 ? u.sel : 3) * SZ_BR : 0u; }
};

template <class Epi, class Sched, bool ALIGN_EPI>
__device__ __forceinline__ void gemm_phase(LAS unsigned char* lds, const Gemm g, const Sched& S, const Epi& E, const int tid) {
    const int wid = __builtin_amdgcn_readfirstlane(tid >> 6), lane = tid & 63, wr = wid >> 2, wc = wid & 3, fr = lane & 15, fq = lane >> 4;
    const int K = g.K, nt = K / BK;
    unsigned voffA[2], voffB[2];
#pragma unroll
    for (int i = 0; i < 2; ++i) { int R, C; stage_rc(tid * 16 + i * 8192, R, C); const int Rb = Epi::PERM ? ((R & ~31) + perm32(R & 31)) : R;
        voffA[i] = (unsigned)(R * g.lda + C) * 2u; voffB[i] = (unsigned)(Rb * g.ldb + C) * 2u; }
    const size_t kstep = (size_t)(BK * 2);
    const size_t hsA = (size_t)HALF * g.lda * 2, hsB = (size_t)HALF * g.ldb * 2;
    const size_t tsA = 2 * hsA, tsB = 2 * hsB;
    const unsigned ldsw = (unsigned)wid * 1024u;
    const int aoff = lds_byte(wr * 64 + fr, fq * 8), boff = lds_byte(wc * 32 + fr, fq * 8);
#define PG8_SA(b, h) (((b) * 2 + (h)) * HTB)
#define PG8_SB(b, h) ((4 + (b) * 2 + (h)) * HTB)
#define PG8_STAGE(bufoff, gbase, voff) do { _Pragma("unroll") for (int _i = 0; _i < 2; ++_i) \
        __builtin_amdgcn_global_load_lds((const unsigned*)((const char*)(gbase) + (voff)[_i]), (LAS unsigned*)(lds + (bufoff) + ldsw + _i * 8192), 16, 0, 0); } while (0)
#define PG8_LDA(dst, b, h) do { _Pragma("unroll") for (int m = 0; m < 4; ++m) _Pragma("unroll") for (int k = 0; k < 2; ++k) dst[m][k] = *(const LAS bf16x8*)(lds + PG8_SA(b, h) + aoff + m * 2048 + k * 1024); } while (0)
#define PG8_LDB(dst, b, h) do { _Pragma("unroll") for (int n = 0; n < 2; ++n) _Pragma("unroll") for (int k = 0; k < 2; ++k) dst[n][k] = *(const LAS bf16x8*)(lds + PG8_SB(b, h) + boff + n * 2048 + k * 1024); } while (0)
#define PG8_MMA(ai, bj, At, Bt) do { __builtin_amdgcn_s_setprio(1); _Pragma("unroll") for (int m = 0; m < 4; ++m) _Pragma("unroll") for (int n = 0; n < 2; ++n) _Pragma("unroll") for (int k = 0; k < 2; ++k) \
        acc[ai][bj][m][n] = __builtin_amdgcn_mfma_f32_16x16x32_bf16(Bt[n][k], At[m][k], acc[ai][bj][m][n], 0, 0, 0); __builtin_amdgcn_s_setprio(0); } while (0)
#define PG8_WAIT_V(n) asm volatile("s_waitcnt vmcnt(" #n ")" ::: "memory")
#define PG8_WAIT_L(n) asm volatile("s_waitcnt lgkmcnt(" #n ")" ::: "memory")
#define PG8_BAR __builtin_amdgcn_s_barrier()
#define PG8_SCHED __builtin_amdgcn_sched_barrier(0)
    Unit cur, nxt; int ui = 0;
    if (!S.next(0, cur)) return;
    f32x4 acc[2][2][4][2];
#pragma unroll
    for (int a = 0; a < 2; ++a)
#pragma unroll
        for (int b = 0; b < 2; ++b)
#pragma unroll
            for (int m = 0; m < 4; ++m)
#pragma unroll
                for (int n = 0; n < 2; ++n) acc[a][b][m][n] = (f32x4){0.f, 0.f, 0.f, 0.f};
    bf16x8 At[4][2], B0[2][2], B1[2][2];
    const char* cA = (const char*)g.A + (size_t)cur.pm * tsA + S.aoff(cur);
    const char* cB = (const char*)g.Bt + (size_t)cur.pn * tsB + (size_t)(cur.pm >> g.bshift) * g.bgs * 2 + S.boff(cur);
    PG8_STAGE(PG8_SB(0, 0), cB, voffB); PG8_STAGE(PG8_SB(0, 1), cB + hsB, voffB); PG8_STAGE(PG8_SA(0, 0), cA, voffA); PG8_STAGE(PG8_SA(0, 1), cA + hsA, voffA);
    if (wr == 1) PG8_BAR;
    PG8_WAIT_V(2); PG8_BAR;
    PG8_STAGE(PG8_SB(1, 0), cB + kstep, voffB); PG8_STAGE(PG8_SA(1, 0), cA + kstep, voffA); PG8_STAGE(PG8_SB(1, 1), cB + hsB + kstep, voffB);
    PG8_WAIT_V(6); PG8_BAR;
    for (;;) {
        const bool has_next = S.next(ui + 1, nxt);
        const char* nA = has_next ? (const char*)g.A + (size_t)nxt.pm * tsA + S.aoff(nxt) : cA;
        const char* nB = has_next ? (const char*)g.Bt + (size_t)nxt.pn * tsB + (size_t)(nxt.pm >> g.bshift) * g.bgs * 2 + S.boff(nxt) : cB;
        for (int t = 0; t < nt; t += 2) {
            const bool last = (t == nt - 2);
            const char* a1 = cA + (size_t)(t + 1) * kstep;
            const char* a2 = last ? nA : cA + (size_t)(t + 2) * kstep; const char* b2 = last ? nB : cB + (size_t)(t + 2) * kstep;
            const char* a3 = a2 + kstep; const char* b3 = b2 + kstep;
            PG8_LDB(B0, 0, 0); PG8_LDB(B1, 0, 1); PG8_SCHED; PG8_LDA(At, 0, 0); PG8_STAGE(PG8_SA(1, 1), a1 + hsA, voffA);
            PG8_WAIT_V(8); PG8_WAIT_L(0); PG8_BAR; PG8_MMA(0, 0, At, B0); PG8_MMA(0, 1, At, B1); PG8_BAR; PG8_SCHED;
            PG8_LDA(At, 0, 1); PG8_STAGE(PG8_SB(0, 0), b2, voffB); PG8_STAGE(PG8_SB(0, 1), b2 + hsB, voffB); PG8_STAGE(PG8_SA(0, 0), a2, voffA);
            PG8_WAIT_V(8); PG8_WAIT_L(0); PG8_BAR; PG8_MMA(1, 0, At, B0); PG8_MMA(1, 1, At, B1); PG8_BAR; PG8_SCHED;
            PG8_LDB(B0, 1, 0); PG8_LDB(B1, 1, 1); PG8_SCHED; PG8_LDA(At, 1, 0); PG8_STAGE(PG8_SA(0, 1), a2 + hsA, voffA);
            PG8_WAIT_V(8); PG8_WAIT_L(0); PG8_BAR; PG8_MMA(0, 0, At, B0); PG8_MMA(0, 1, At, B1); PG8_BAR; PG8_SCHED;
            PG8_LDA(At, 1, 1); PG8_STAGE(PG8_SB(1, 0), b3, voffB); PG8_STAGE(PG8_SB(1, 1), b3 + hsB, voffB); PG8_STAGE(PG8_SA(1, 0), a3, voffA);
            PG8_WAIT_V(8); PG8_WAIT_L(0); PG8_BAR; PG8_MMA(1, 0, At, B0); PG8_MMA(1, 1, At, B1); PG8_BAR; PG8_SCHED;
        }
        if constexpr (ALIGN_EPI) { if (wr == 0) PG8_BAR; }
        E(acc, cur, wr, wc, fr, fq);
        if (!has_next) break;
#pragma unroll
        for (int a = 0; a < 2; ++a)
#pragma unroll
            for (int b = 0; b < 2; ++b)
#pragma unroll
                for (int m = 0; m < 4; ++m)
#pragma unroll
                    for (int n = 0; n < 2; ++n) acc[a][b][m][n] = (f32x4){0.f, 0.f, 0.f, 0.f};
        cur = nxt; cA = nA; cB = nB; ++ui;
        if constexpr (ALIGN_EPI) { if (wr == 1) PG8_BAR; }
    }
    PG8_WAIT_V(0);
    if constexpr (!ALIGN_EPI) { if (wr == 0) PG8_BAR; }
    PG8_BAR;
#undef PG8_SA
#undef PG8_SB
#undef PG8_STAGE
#undef PG8_LDA
#undef PG8_LDB
#undef PG8_MMA
#undef PG8_WAIT_V
#undef PG8_WAIT_L
#undef PG8_BAR
#undef PG8_SCHED
}

typedef const f32x4 (&AccRef)[2][2][4][2];
enum { EM_FB16 = 0, EM_BF16 = 1, EM_SWIGLU = 2, EM_MIXIN = 3, EM_BR0 = 4, EM_BR1 = 5, EM_GLU = 6, EM_S5Y = 7, EM_F32Z = 8, EM_BR2 = 9, EM_BRANCH = 10 };
struct GEpi {
    static constexpr bool PERM = true;
    int mode_; int gcol_; unsigned char* ws; const float* dskip;
    __device__ __forceinline__ void operator()(AccRef acc, const Unit& u, int wr, int wc, int fr, int fq) const {
        const int mode = mode_ == EM_BRANCH ? (u.sel == 0 ? EM_BR0 : (u.sel == 1 ? EM_BR1 : (u.sel == 2 ? EM_BR2 : EM_GLU))) : mode_;
        const int gcol = mode_ == EM_BRANCH ? (u.sel == 0 ? 2048 : (u.sel == 1 ? 4096 : 5120)) : gcol_;
        float* of = (float*)(ws + WS_Z); const float* pf = dskip;
        bf16_t* ob = (bf16_t*)(ws + (mode == EM_BF16 ? WS_VT : (mode == EM_GLU || mode == EM_BR2 ? WS_H : (mode == EM_S5Y ? WS_ACAT : (mode == EM_FB16 || mode == EM_BR0 ? WS_F : (mode == EM_BR1 ? WS_F + (size_t)T_ * D_ * 2 : WS_P))))));
        bf16_t* ob2 = (bf16_t*)(ws + WS_ASSM); const bf16_t* pb = (const bf16_t*)(ws + (mode == EM_S5Y ? WS_ASSM : WS_P));
        const int ldc = mode == EM_F32Z ? 256 : (mode == EM_BF16 ? T_ : (mode == EM_SWIGLU ? FF_ : D_));
        const int row0 = u.pm * BM + wr * 64 + fr;
        if (mode == EM_F32Z) {
#pragma unroll
            for (int ai = 0; ai < 2; ++ai)
#pragma unroll
                for (int m = 0; m < 4; ++m) { float* rowp = of + (size_t)(row0 + ai * HALF + m * 16) * ldc + u.pn * BM + wc * 32 + 8 * fq;
#pragma unroll
                    for (int bj = 0; bj < 2; ++bj) { *(f32x4*)(rowp + bj * HALF) = acc[ai][bj][m][0]; *(f32x4*)(rowp + bj * HALF + 4) = acc[ai][bj][m][1]; } }
        } else if (mode == EM_BF16 || mode == EM_FB16) {
#pragma unroll
            for (int ai = 0; ai < 2; ++ai)
#pragma unroll
                for (int m = 0; m < 4; ++m) { bf16_t* rowp = ob + (size_t)(row0 + ai * HALF + m * 16) * ldc + u.pn * BM + wc * 32 + 8 * fq;
#pragma unroll
                    for (int bj = 0; bj < 2; ++bj) { const f32x4 v0 = acc[ai][bj][m][0], v1 = acc[ai][bj][m][1];
                        u32x4 w; w.x = cvt_pk_bf16(v0[0], v0[1]); w.y = cvt_pk_bf16(v0[2], v0[3]); w.z = cvt_pk_bf16(v1[0], v1[1]); w.w = cvt_pk_bf16(v1[2], v1[3]);
                        *(u32x4*)(rowp + bj * HALF) = w; } }
        } else if (mode == EM_SWIGLU) {
#pragma unroll
            for (int ai = 0; ai < 2; ++ai)
#pragma unroll
                for (int m = 0; m < 4; ++m) { bf16_t* rowp = ob + (size_t)(row0 + ai * HALF + m * 16) * ldc + u.pn * HALF + wc * 32 + 8 * fq;
                    float v[8];
#pragma unroll
                    for (int n = 0; n < 2; ++n)
#pragma unroll
                        for (int i = 0; i < 4; ++i) { const float a = acc[ai][0][m][n][i], b = acc[ai][1][m][n][i]; v[4 * n + i] = a * sigmoidf_(a) * b; }
                    *(u32x4*)rowp = pack8(v); }
        } else if (mode == EM_MIXIN) {
            const bool ssm = u.pn == 3;
#pragma unroll
            for (int ai = 0; ai < 2; ++ai)
#pragma unroll
                for (int m = 0; m < 4; ++m) { const int r = row0 + ai * HALF + m * 16;
#pragma unroll
                    for (int bj = 0; bj < 2; ++bj) { const int cl = bj * HALF + wc * 32 + 8 * fq;
                        float v[8];
#pragma unroll
                        for (int n = 0; n < 2; ++n)
#pragma unroll
                            for (int i = 0; i < 4; ++i) v[4 * n + i] = acc[ai][bj][m][n][i];
                        bf16_t* dst = ssm ? ob2 + ((size_t)((cl >> 4) * 1024 + (r >> 4))) * 384 + (r & 15) * 16 + (cl & 15)
                                          : ob + (size_t)r * NIN + u.pn * BM + cl;
                        *(u32x4*)dst = pack8(v); } }
        } else if (mode == EM_BR0 || mode == EM_BR1 || mode == EM_BR2) {
#pragma unroll
            for (int ai = 0; ai < 2; ++ai)
#pragma unroll
                for (int m = 0; m < 4; ++m) { const int r = row0 + ai * HALF + m * 16;
#pragma unroll
                    for (int bj = 0; bj < 2; ++bj) { const int col = u.pn * BM + bj * HALF + wc * 32 + 8 * fq;
                        float gt[8]; unpack8(*(const u32x4*)(pb + (size_t)r * NIN + gcol + col), gt);
                        float v[8];
#pragma unroll
                        for (int i = 0; i < 4; ++i) { v[i] = gt[i] * acc[ai][bj][m][0][i]; v[4 + i] = gt[4 + i] * acc[ai][bj][m][1][i]; }
                        *(u32x4*)(ob + (size_t)r * D_ + col) = pack8(v); } }
        } else if (mode == EM_GLU) {
            const int col = u.pn * HALF + wc * 32 + 8 * fq;
            const bf16_t* g0 = (const bf16_t*)(ws + WS_F); const bf16_t* g1 = g0 + (size_t)T_ * D_;
#pragma unroll
            for (int ai = 0; ai < 2; ++ai)
#pragma unroll
                for (int m = 0; m < 4; ++m) { const int r = row0 + ai * HALF + m * 16;
                    float gt[8], p0[8], p1[8], p2[8];
                    unpack8(*(const u32x4*)(pb + (size_t)r * NIN + 2048 + 1024 + col), gt);
                    unpack8(*(const u32x4*)(g0 + (size_t)r * D_ + col), p0); unpack8(*(const u32x4*)(g1 + (size_t)r * D_ + col), p1); unpack8(*(const u32x4*)(ob + (size_t)r * D_ + col), p2);
                    float v[8];
#pragma unroll
                    for (int n = 0; n < 2; ++n)
#pragma unroll
                        for (int i = 0; i < 4; ++i) { const float a = acc[ai][0][m][n][i], g = acc[ai][1][m][n][i];
                            v[4 * n + i] = (p0[4 * n + i] + p1[4 * n + i]) + (p2[4 * n + i] + gt[4 * n + i] * a * sigmoidf_(g)); }
                    *(u32x4*)(ob + (size_t)r * D_ + col) = pack8(v); }
        } else {
#pragma unroll
            for (int ai = 0; ai < 2; ++ai)
#pragma unroll
                for (int m = 0; m < 4; ++m) { const int r = row0 + ai * HALF + m * 16, g = r >> 10, chunk = r & 1023;
#pragma unroll
                    for (int bj = 0; bj < 2; ++bj) { const int cl = bj * HALF + wc * 32 + 8 * fq, ii = cl >> 4, h0 = cl & 15;
                        float uu[8]; unpack8(*(const u32x4*)(pb + (size_t)r * 384 + cl), uu);
                        const f32x4 d0 = *(const f32x4*)(pf + g * 16 + h0), d1 = *(const f32x4*)(pf + g * 16 + h0 + 4);
                        float v[8];
#pragma unroll
                        for (int n = 0; n < 2; ++n)
#pragma unroll
                            for (int i = 0; i < 4; ++i) { const float y = acc[ai][bj][m][n][i] + (n == 0 ? d0[i] : d1[i]) * uu[4 * n + i];
                                v[4 * n + i] = y * sigmoidf_(1.5957691216f * (y + 0.044715f * y * y * y)); }
                        *(u32x4*)(ob + (size_t)(chunk * 16 + ii) * D_ + 256 + g * 16 + h0) = pack8(v); } }
        }
    }
};
}

#define XB_TMO      128
#define XB_XCNT(j)  (256  + 64 * (j))
#define XB_XSUB(j)  (1280 + 64 * (j))
#define XB_XGEN(j)  (2304 + 64 * (j))
#define XB_TOP      3328
#define XB_TOPGEN   3392
#define XCD_BAR_WORDS 3456
#define XB_SPIN_CAP (1u << 18)

__device__ __forceinline__ unsigned xb_ld(unsigned* p)              { return __hip_atomic_load(p, __ATOMIC_RELAXED, __HIP_MEMORY_SCOPE_AGENT); }
__device__ __forceinline__ unsigned xb_add(unsigned* p, unsigned v) { return __hip_atomic_fetch_add(p, v, __ATOMIC_RELAXED, __HIP_MEMORY_SCOPE_AGENT); }
__device__ __forceinline__ unsigned xb_xcc_id() { return (unsigned)__builtin_amdgcn_s_getreg((3 << 11) | 20) & 0xFu; }
#define XB_SPIN(cond, bar) do { unsigned _sp = 0; while (cond) { __builtin_amdgcn_s_sleep(1); \
    if ((++_sp & 255u) == 0u) { if (xb_ld(&(bar)[XB_TMO])) break; if (_sp > XB_SPIN_CAP) { atomicAdd(&(bar)[XB_TMO], 1u); break; } } } } while (0)

struct XcdBarrier {
    unsigned* bar; unsigned x;
    volatile LAS unsigned* st;
};

__device__ __forceinline__ XcdBarrier xcd_barrier_post(unsigned* bar, volatile LAS unsigned* st) {
    XcdBarrier b; b.bar = bar; b.x = xb_xcc_id(); b.st = st;
    if (threadIdx.x == 0) (void)xb_add(&bar[XB_XCNT(b.x)], 1u);
    return b;
}
__device__ __forceinline__ void xcd_barrier_complete(unsigned* bar, unsigned x, unsigned& nloc, unsigned& nx) {
    const unsigned G = gridDim.x * gridDim.y * gridDim.z;
    unsigned sum, cnt, mine, sp = 0u;
    for (;;) {
        sum = 0u; cnt = 0u; mine = 0u;
#pragma unroll
        for (unsigned j = 0; j < 16; ++j) { const unsigned c = xb_ld(&bar[XB_XCNT(j)]); sum += c; cnt += (c > 0u) ? 1u : 0u; mine = (j == x) ? c : mine; }
        if (sum == G) break;
        __builtin_amdgcn_s_sleep(1);
        if ((++sp & 255u) == 0u) { if (xb_ld(&bar[XB_TMO])) break; if (sp > XB_SPIN_CAP) { atomicAdd(&bar[XB_TMO], 1u); break; } }
    }
    nloc = mine > 0u ? mine : 1u; nx = cnt > 0u ? cnt : 1u;
}

__device__ __forceinline__ void xcd_barrier(const XcdBarrier& b) {
    asm volatile("s_waitcnt vmcnt(0)" ::: "memory");
    __syncthreads();
    if (threadIdx.x == 0) {
        unsigned* bar = b.bar;
        __builtin_amdgcn_s_waitcnt(0);
        unsigned nloc = b.st[0], nx = b.st[1];
        if (nloc == 0u) { xcd_barrier_complete(bar, b.x, nloc, nx); b.st[0] = nloc; b.st[1] = nx; }
        const unsigned old = xb_add(&bar[XB_XSUB(b.x)], 1u);
        const unsigned gen = old / nloc;
        if (old + 1u == (gen + 1u) * nloc) {
            __builtin_amdgcn_fence(__ATOMIC_RELEASE, "agent");
            asm volatile("s_waitcnt vmcnt(0)" ::: "memory");
            const unsigned og = xb_add(&bar[XB_TOP], 1u);
            const unsigned tg = og / nx;
            if (og + 1u == (tg + 1u) * nx) xb_add(&bar[XB_TOPGEN], 1u);
            else XB_SPIN(xb_ld(&bar[XB_TOPGEN]) == tg, bar);
            __builtin_amdgcn_fence(__ATOMIC_ACQUIRE, "agent");
            xb_add(&bar[XB_XGEN(b.x)], 1u);
            asm volatile("s_waitcnt vmcnt(0)" ::: "memory");
        } else {
            XB_SPIN(xb_ld(&bar[XB_XGEN(b.x)]) == gen, bar);
            __builtin_amdgcn_fence(__ATOMIC_ACQUIRE, "agent");
            asm volatile("s_waitcnt vmcnt(0)" ::: "memory");
        }
    }
    __syncthreads();
}

struct Args { const float* in[25]; float* out; unsigned char* ws; int ph_lo, ph_hi, coop, pad; };
struct Ctx {
    LAS const unsigned long long* tab; unsigned char* ws;
    __device__ __forceinline__ const float* in(int i) const { const unsigned long long v = tab[i];
        const unsigned lo = __builtin_amdgcn_readfirstlane((unsigned)v), hi = __builtin_amdgcn_readfirstlane((unsigned)(v >> 32));
        return (const float*)(GAS const float*)(((unsigned long long)hi << 32) | lo); }
};

struct TItem { const float* src; bf16_t* dst; int N, K, dst_row0, k0, n0; float scale; };
constexpr int IT_FFIN = (D_ / 64) * (2 * FF_ / 32), IT_FFOUT = (FF_ / 64) * (D_ / 32), IT_WIN = (D_ / 64) * (NIN / 32);
constexpr int IT_BR = (256 / 64) * (D_ / 32), IT_GLU = (256 / 64) * (2048 / 32), IT_WOUT = (D_ / 64) * (D_ / 32), IT_POOL = 4 * 16;
constexpr int IT_TILES = 2 * IT_FFIN + 2 * IT_FFOUT + IT_WIN + 2 * IT_BR + IT_GLU + IT_WOUT;

__device__ __forceinline__ void t_decode(const Ctx& a, int it, TItem& t) {
    const int l = it / IT_TILES; int r = it % IT_TILES;
    unsigned char* wl = a.ws + WS_W + (size_t)l * LAYER_W;
    t.scale = 1.f;
    if (r < 2 * IT_FFIN) { const int s = r / IT_FFIN; r %= IT_FFIN; const int nblk = 2 * FF_ / 32, kb = r / nblk, nb = r % nblk, n0 = 32 * nb;
        const int half = n0 >= FF_, j = n0 - half * FF_;
        t.src = a.in(6) + (size_t)(l * 2 + s) * D_ * 2 * FF_; t.N = 2 * FF_; t.K = D_; t.dst = (bf16_t*)(wl + OFF_FFIN0 + s * SZ_FFIN); t.dst_row0 = 256 * (j >> 7) + 128 * half + (j & 127); t.k0 = 64 * kb; t.n0 = n0; return; }
    r -= 2 * IT_FFIN;
    if (r < 2 * IT_FFOUT) { const int s = r / IT_FFOUT; r %= IT_FFOUT; const int nblk = D_ / 32, kb = r / nblk, nb = r % nblk;
        t.src = a.in(7) + (size_t)(l * 2 + s) * FF_ * D_; t.N = D_; t.K = FF_; t.dst = (bf16_t*)(wl + OFF_FFOUT0 + s * SZ_FFOUT); t.dst_row0 = 32 * nb; t.k0 = 64 * kb; t.n0 = 32 * nb; return; }
    r -= 2 * IT_FFOUT;
    if (r < IT_WIN) { const int nblk = NIN / 32, kb = r / nblk, nb = r % nblk, n0 = 32 * nb;
        t.scale = (n0 >= 1280 && n0 < 1536) ? 0.125f : 1.f;
        t.src = a.in(8) + (size_t)l * D_ * NIN; t.N = NIN; t.K = D_; t.dst = (bf16_t*)(wl + OFF_WIN); t.dst_row0 = n0; t.k0 = 64 * kb; t.n0 = n0; return; }
    r -= IT_WIN;
    if (r < 2 * IT_BR) { const int s = r / IT_BR; r %= IT_BR; const int nblk = D_ / 32, kb = r / nblk, nb = r % nblk;
        t.src = a.in(s == 0 ? 10 : 23) + (size_t)l * 256 * D_; t.N = D_; t.K = 256; t.dst = (bf16_t*)(wl + (s == 0 ? OFF_WCONV : OFF_WSB)); t.dst_row0 = 32 * nb; t.k0 = 64 * kb; t.n0 = 32 * nb; return; }
    r -= 2 * IT_BR;
    if (r < IT_GLU) { const int nblk = 2048 / 32, kb = r / nblk, nb = r % nblk, n0 = 32 * nb; const int half = n0 >= 1024, j = n0 - half * 1024;
        t.src = a.in(19) + (size_t)l * 256 * 2048; t.N = 2048; t.K = 256; t.dst = (bf16_t*)(wl + OFF_WGLU); t.dst_row0 = 256 * (j >> 7) + 128 * half + (j & 127); t.k0 = 64 * kb; t.n0 = n0; return; }
    r -= IT_GLU;
    { const int nblk = D_ / 32, kb = r / nblk, nb = r % nblk;
        t.src = a.in(24) + (size_t)l * D_ * D_; t.N = D_; t.K = D_; t.dst = (bf16_t*)(wl + OFF_WOUT); t.dst_row0 = 32 * nb; t.k0 = 64 * kb; t.n0 = 32 * nb; }
}
__device__ __forceinline__ void t_load(const TItem& t, f32x4 (&r)[8], int lane) {
    const float* p = t.src + (size_t)(t.k0 + (lane >> 3)) * t.N + t.n0 + 4 * (lane & 7);
#pragma unroll
    for (int i = 0; i < 8; ++i) r[i] = *(const f32x4*)(p + (size_t)(8 * i) * t.N);
}
__device__ __forceinline__ void t_finish(const TItem& t, const f32x4 (&r)[8], LAS float* scr, int lane) {
    LAS float* w = scr + (lane >> 3) * 33 + 4 * (lane & 7);
#pragma unroll
    for (int i = 0; i < 8; ++i) { w[(8 * i) * 33 + 0] = r[i].x * t.scale; w[(8 * i) * 33 + 1] = r[i].y * t.scale; w[(8 * i) * 33 + 2] = r[i].z * t.scale; w[(8 * i) * 33 + 3] = r[i].w * t.scale; }
    asm volatile("s_waitcnt lgkmcnt(0)" ::: "memory");
    const int c = lane & 7;
#pragma unroll
    for (int j = 0; j < 4; ++j) { const int n = (lane >> 3) + 8 * j; const LAS float* s = scr + (8 * c) * 33 + n;
        u32x4 o; o.x = cvt_pk_bf16(s[0 * 33], s[1 * 33]); o.y = cvt_pk_bf16(s[2 * 33], s[3 * 33]); o.z = cvt_pk_bf16(s[4 * 33], s[5 * 33]); o.w = cvt_pk_bf16(s[6 * 33], s[7 * 33]);
        *(u32x4*)(t.dst + (size_t)(t.dst_row0 + n) * t.K + t.k0 + 8 * c) = o; }
    asm volatile("s_waitcnt lgkmcnt(0)" ::: "memory");
}
__device__ __forceinline__ void p0_transposes(const Ctx& a, int gw, int ngw, LAS float* scr, int lane) {
    constexpr int NT = DEPTH * IT_TILES;
    int it = gw; TItem ta, tb; f32x4 ra[8], rb[8];
    if (it < NT) { t_decode(a, it, ta); t_load(ta, ra, lane); }
    while (it < NT) {
        const int nx = it + ngw; const bool hn = nx < NT;
        if (hn) { t_decode(a, nx, tb); t_load(tb, rb, lane); }
        t_finish(ta, ra, scr, lane);
        if (hn) { ta = tb;
#pragma unroll
            for (int i = 0; i < 8; ++i) ra[i] = rb[i]; }
        it = nx;
    }
}
__device__ __forceinline__ void p0_pool_item(const Ctx& a, int it, int lane) {
    const int l = it >> 6, r = it & 63;
    unsigned char* wl = a.ws + WS_W + (size_t)l * LAYER_W;
    const int gi = r >> 4, n = (r & 15) * 64 + lane;
    const float* wp = a.in(20) + (size_t)l * 4 * 64 * 64 + (size_t)gi * 64 * 64;
    const float* ps = a.in(21) + (size_t)l * 256 + gi * 64;
    const float* wo = a.in(22) + (size_t)l * 256 * D_ + (size_t)gi * 64 * D_ + n;
    bf16_t* dst = (bf16_t*)(wl + OFF_WPOOL) + (size_t)n * 256 + gi * 64;
    float wv[64];
#pragma unroll
    for (int d = 0; d < 64; ++d) wv[d] = wo[(size_t)d * D_] * ps[d];
    for (int c8 = 0; c8 < 8; ++c8) { float v[8];
#pragma unroll
        for (int cc = 0; cc < 8; ++cc) { const float* wr_ = wp + (c8 * 8 + cc) * 64; float s = 0.f;
#pragma unroll
            for (int d = 0; d < 64; ++d) s += wr_[d] * wv[d];
            v[cc] = s; }
        *(u32x4*)(dst + c8 * 8) = pack8(v); }
}

__device__ __forceinline__ void p0_ada(const Ctx& a, LAS float* lds, int tid, int lane, int wave, int bid, int G) {
    LAS float* cact = lds;
    LAS float* red = lds + 8192;
    for (int i = tid; i < NB * D_; i += 512) { const float c = a.in(1)[i]; cact[i] = c * sigmoidf_(c); }
    __syncthreads();
    float* ADA = (float*)(a.ws + WS_ADA);
    for (int it = bid; it < DEPTH * 36; it += G) {
        const int l = it / 36, col0 = (it % 36) * 256;
        const int kb = wave * 128;
        const float* w = a.in(2) + (size_t)l * D_ * 9216 + (size_t)kb * 9216 + col0 + 4 * lane;
        f32x4 acc[8];
#pragma unroll
        for (int b = 0; b < 8; ++b) acc[b] = (f32x4){0.f, 0.f, 0.f, 0.f};
#pragma unroll 2
        for (int k4 = 0; k4 < 32; ++k4) {
            f32x4 wv[4];
#pragma unroll
            for (int j = 0; j < 4; ++j) wv[j] = *(const f32x4*)(w + (size_t)(4 * k4 + j) * 9216);
#pragma unroll
            for (int b = 0; b < 8; ++b) { const f32x4 c = *(const LAS f32x4*)(cact + b * 1024 + kb + 4 * k4);
                acc[b] += c.x * wv[0] + c.y * wv[1] + c.z * wv[2] + c.w * wv[3]; }
        }
#pragma unroll
        for (int b = 0; b < 8; ++b) *(LAS f32x4*)(red + (wave * 8 + b) * 256 + 4 * lane) = acc[b];
        __syncthreads();
        { const int b = tid >> 6, c4 = (tid & 63) * 4; f32x4 s = *(const f32x4*)(a.in(3) + (size_t)l * 9216 + col0 + c4);
#pragma unroll
          for (int w2 = 0; w2 < 8; ++w2) s += *(const LAS f32x4*)(red + (w2 * 8 + b) * 256 + c4);
          *(f32x4*)(ADA + ((size_t)l * 8 + b) * 9216 + col0 + c4) = s; }
        __syncthreads();
    }
}

__device__ __forceinline__ void p0_tables(const Ctx& a, int gt, int ngt) {
    float* APOW = (float*)(a.ws + WS_APOW); float* BB = (float*)(a.ws + WS_BB);
    for (int i = gt; i < DEPTH * 16 * 64; i += ngt) {
        const int l = i >> 10, g = (i >> 6) & 15;
        const float lr = fminf(a.in(11)[i], -1e-4f), li = a.in(12)[i], dt = __expf(a.in(13)[l * 16 + g]);
        float abr = 1.f, abi = 0.f;
        for (int tau = 0; tau <= 16; ++tau) {
            const float mg = __expf((float)tau * lr * dt);
            float rev = (float)tau * li * dt * 0.15915494309189535f; rev -= floorf(rev);
            const float cr = mg * __builtin_amdgcn_cosf(rev), ci = mg * __builtin_amdgcn_sinf(rev);
            APOW[((size_t)i * 17 + tau) * 2] = cr; APOW[((size_t)i * 17 + tau) * 2 + 1] = ci;
            if (tau == 1) { abr = cr; abi = ci; }
        }
        const float den = lr * lr + li * li, nr = abr - 1.0f;
        const float fre = (nr * lr + abi * li) / den, fim = (abi * lr - nr * li) / den;
        for (int h = 0; h < 16; ++h) { const float br = a.in(14)[(size_t)i * 16 + h], bi = a.in(15)[(size_t)i * 16 + h];
            BB[((size_t)i * 16 + h) * 2] = fre * br - fim * bi; BB[((size_t)i * 16 + h) * 2 + 1] = fre * bi + fim * br; }
    }
}
__device__ __forceinline__ void p1_kern(const Ctx& a, int gt, int ngt) {
    const float* APOW = (const float*)(a.ws + WS_APOW); const float* BB = (const float*)(a.ws + WS_BB); float* KERN = (float*)(a.ws + WS_KERN);
    for (int i = gt; i < DEPTH * 16 * 16 * 256; i += ngt) {
        const int hp = i & 15, h = (i >> 4) & 15, tau = (i >> 8) & 15, lg = i >> 12;
        const float* cre = a.in(16) + ((size_t)lg * 16 + h) * 64; const float* cim = a.in(17) + ((size_t)lg * 16 + h) * 64;
        float s = 0.f;
        for (int p = 0; p < 64; ++p) {
            const float ar = APOW[(((size_t)lg * 64 + p) * 17 + tau) * 2], ai = APOW[(((size_t)lg * 64 + p) * 17 + tau) * 2 + 1];
            const float br = BB[(((size_t)lg * 64 + p) * 16 + hp) * 2], bi = BB[(((size_t)lg * 64 + p) * 16 + hp) * 2 + 1];
            const float cr = cre[p], ci = cim[p];
            const float car = cr * ar - ci * ai, cai = cr * ai + ci * ar;
            s += car * br - cai * bi;
        }
        KERN[i] = s;
    }
}
__device__ __forceinline__ void p2_fill(const Ctx& a, int gt, int ngt) {
    const float* APOW = (const float*)(a.ws + WS_APOW); const float* BB = (const float*)(a.ws + WS_BB); const float* KERN = (const float*)(a.ws + WS_KERN);
    constexpr int TMC = 16 * 256 * 48, WZC = 16 * 256 * 32;
    for (int it = gt; it < DEPTH * (TMC + WZC); it += ngt) {
        const int l = it / (TMC + WZC); int r = it % (TMC + WZC);
        unsigned char* wl = a.ws + WS_W + (size_t)l * LAYER_W;
        float v[8];
        if (r < TMC) {
            const int kc = r % 48, n = (r / 48) & 255, g = r / (48 * 256), i = n >> 4, h = n & 15, lg = l * 16 + g;
            if (kc < 32) { const int j = kc >> 1, hp0 = (kc & 1) * 8;
#pragma unroll
                for (int q = 0; q < 8; ++q) v[q] = (j <= i) ? KERN[(((size_t)lg * 16 + (i - j)) * 16 + h) * 16 + hp0 + q] : 0.f;
            } else { const int p0 = (kc - 32) * 4;
#pragma unroll
                for (int q = 0; q < 4; ++q) { const int p = p0 + q;
                    const float ar = APOW[(((size_t)lg * 64 + p) * 17 + i + 1) * 2], ai = APOW[(((size_t)lg * 64 + p) * 17 + i + 1) * 2 + 1];
                    const float cr = a.in(16)[((size_t)lg * 16 + h) * 64 + p], ci = a.in(17)[((size_t)lg * 16 + h) * 64 + p];
                    v[2 * q] = cr * ar - ci * ai; v[2 * q + 1] = -(cr * ai + ci * ar); } }
            *(u32x4*)((bf16_t*)(wl + OFF_TM) + ((size_t)g * 256 + n) * 384 + kc * 8) = pack8(v);
        } else {
            r -= TMC;
            const int kc = r & 31, n = (r >> 5) & 255, g = r >> 13, lg = l * 16 + g;
            if (n < 128) { const int p = n >> 1, part = n & 1, j = kc >> 1, hp0 = (kc & 1) * 8;
                const float ar = APOW[(((size_t)lg * 64 + p) * 17 + 15 - j) * 2], ai = APOW[(((size_t)lg * 64 + p) * 17 + 15 - j) * 2 + 1];
#pragma unroll
                for (int q = 0; q < 8; ++q) { const float br = BB[(((size_t)lg * 64 + p) * 16 + hp0 + q) * 2], bi = BB[(((size_t)lg * 64 + p) * 16 + hp0 + q) * 2 + 1];
                    v[q] = part ? (ar * bi + ai * br) : (ar * br - ai * bi); }
            } else {
#pragma unroll
                for (int q = 0; q < 8; ++q) v[q] = 0.f; }
            *(u32x4*)((bf16_t*)(wl + OFF_WZ) + ((size_t)g * 256 + n) * 256 + kc * 8) = pack8(v);
        }
    }
}

__device__ __forceinline__ void rowop(const float* xin32, const bf16_t* xinb, float* xout32, bf16_t* xoutb, const bf16_t* f, float resw, const float* ada_gate  , const float* gpost,
                                      bool do_h, const float* ada_mod  , const float* gpre, bf16_t* H, int gw, int ngw, int lane) {
    constexpr int NR = 4;
    for (int row0 = gw; row0 < T_; row0 += NR * ngw) {
        f32x4 xv[NR][4]; f32x4 fv[NR][4]; float ss[NR];
#pragma unroll
        for (int q = 0; q < NR; ++q) { const int row = (row0 + q * ngw) < T_ ? row0 + q * ngw : row0; const size_t ro = (size_t)row * D_ + 4 * lane;
#pragma unroll
            for (int j = 0; j < 4; ++j) { if (xin32) xv[q][j] = *(const f32x4*)(xin32 + ro + 256 * j);
                else { const u32x2 xw = *(const u32x2*)(xinb + ro + 256 * j); xv[q][j] = (f32x4){bf_lo(xw.x), bf_hi(xw.x), bf_lo(xw.y), bf_hi(xw.y)}; } }
            ss[q] = 0.f;
            if (f) {
#pragma unroll
                for (int j = 0; j < 4; ++j) { const u32x2 fw = *(const u32x2*)(f + ro + 256 * j); fv[q][j] = (f32x4){bf_lo(fw.x), bf_hi(fw.x), bf_lo(fw.y), bf_hi(fw.y)};
                    ss[q] += (fv[q][j].x * fv[q][j].x + fv[q][j].y * fv[q][j].y) + (fv[q][j].z * fv[q][j].z + fv[q][j].w * fv[q][j].w); } } }
#pragma unroll
        for (int q = 0; q < NR; ++q) { if ((row0 + q * ngw) >= T_) break;
            const int row = row0 + q * ngw, b = row >> 11; const size_t ro = (size_t)row * D_ + 4 * lane;
            if (f) {
                const float rs = rsqrtf(wave_sum(ss[q], lane) * (1.f / D_) + EPS_);
#pragma unroll
                for (int j = 0; j < 4; ++j) { const f32x4 gp = *(const f32x4*)(gpost + 4 * lane + 256 * j), gt = *(const f32x4*)(ada_gate + (size_t)b * 9216 + 4 * lane + 256 * j);
                    xv[q][j] = xv[q][j] + (resw * (gt + 1.0f)) * (fv[q][j] * rs * gp); }
            }
#pragma unroll
            for (int j = 0; j < 4; ++j) { if (xout32) *(f32x4*)(xout32 + ro + 256 * j) = xv[q][j];
                else { u32x2 w; w.x = cvt_pk_bf16(xv[q][j].x, xv[q][j].y); w.y = cvt_pk_bf16(xv[q][j].z, xv[q][j].w); *(u32x2*)(xoutb + ro + 256 * j) = w; } }
            if (do_h) {
                float s2 = 0.f;
#pragma unroll
                for (int j = 0; j < 4; ++j) s2 += (xv[q][j].x * xv[q][j].x + xv[q][j].y * xv[q][j].y) + (xv[q][j].z * xv[q][j].z + xv[q][j].w * xv[q][j].w);
                const float rs = rsqrtf(wave_sum(s2, lane) * (1.f / D_) + EPS_);
#pragma unroll
                for (int j = 0; j < 4; ++j) { const f32x4 gp = *(const f32x4*)(gpre + 4 * lane + 256 * j);
                    const f32x4 sh = *(const f32x4*)(ada_mod + (size_t)b * 9216 + 4 * lane + 256 * j), sc = *(const f32x4*)(ada_mod + (size_t)b * 9216 + 1024 + 4 * lane + 256 * j);
                    const f32x4 hv = (xv[q][j] * rs * gp) * (sc + 1.0f) + sh;
                    u32x2 w; w.x = cvt_pk_bf16(hv.x, hv.y); w.y = cvt_pk_bf16(hv.z, hv.w);
                    *(u32x2*)(H + ro + 256 * j) = w; }
            }
        }
    }
}

__device__ __forceinline__ void rowop_c(const float* xin32, const bf16_t* xinb, float* xout32, bf16_t* xoutb, const bf16_t* f, float resw, const float* ada_gate, const float* gpost,
                                        bool do_h, const float* ada_mod, const float* gpre, bf16_t* H, int gw, int lane) {
    constexpr int RPW = 8;
    const int rbeg = gw * RPW, b = rbeg >> 11;
    f32x4 cg[4], gpr[4], sh[4];
#pragma unroll
    for (int j = 0; j < 4; ++j) { cg[j] = (f32x4){0.f, 0.f, 0.f, 0.f}; gpr[j] = cg[j]; sh[j] = cg[j];
        if (f) { const f32x4 gpo = *(const f32x4*)(gpost + 4 * lane + 256 * j), gt = *(const f32x4*)(ada_gate + (size_t)b * 9216 + 4 * lane + 256 * j); cg[j] = (resw * (gt + 1.0f)) * gpo; }
        if (do_h) { const f32x4 gp = *(const f32x4*)(gpre + 4 * lane + 256 * j), sc = *(const f32x4*)(ada_mod + (size_t)b * 9216 + 1024 + 4 * lane + 256 * j);
            gpr[j] = gp * (sc + 1.0f); sh[j] = *(const f32x4*)(ada_mod + (size_t)b * 9216 + 4 * lane + 256 * j); } }
    u32x2 xr[RPW][4], fr[RPW][4]; f32x4 x32[RPW][4];
#pragma unroll
    for (int q = 0; q < RPW; ++q) { const size_t ro = (size_t)(rbeg + q) * D_ + 4 * lane;
#pragma unroll
        for (int j = 0; j < 4; ++j) {
            if (xin32) x32[q][j] = *(const f32x4*)(xin32 + ro + 256 * j); else xr[q][j] = *(const u32x2*)(xinb + ro + 256 * j);
            if (f) fr[q][j] = *(const u32x2*)(f + ro + 256 * j); } }
#pragma unroll
    for (int q = 0; q < RPW; ++q) { const size_t ro = (size_t)(rbeg + q) * D_ + 4 * lane;
        f32x4 xv[4]; float s2 = 0.f;
#pragma unroll
        for (int j = 0; j < 4; ++j) xv[j] = xin32 ? x32[q][j] : (f32x4){bf_lo(xr[q][j].x), bf_hi(xr[q][j].x), bf_lo(xr[q][j].y), bf_hi(xr[q][j].y)};
        if (f) { f32x4 fv[4]; float ss = 0.f;
#pragma unroll
            for (int j = 0; j < 4; ++j) { fv[j] = (f32x4){bf_lo(fr[q][j].x), bf_hi(fr[q][j].x), bf_lo(fr[q][j].y), bf_hi(fr[q][j].y)};
                ss += (fv[j].x * fv[j].x + fv[j].y * fv[j].y) + (fv[j].z * fv[j].z + fv[j].w * fv[j].w); }
            const float rs = rsqrtf(wave_sum(ss, lane) * (1.f / D_) + EPS_);
#pragma unroll
            for (int j = 0; j < 4; ++j) xv[j] = xv[j] + cg[j] * (fv[j] * rs); }
#pragma unroll
        for (int j = 0; j < 4; ++j) { s2 += (xv[j].x * xv[j].x + xv[j].y * xv[j].y) + (xv[j].z * xv[j].z + xv[j].w * xv[j].w);
            if (xout32) *(f32x4*)(xout32 + ro + 256 * j) = xv[j];
            else { u32x2 w; w.x = cvt_pk_bf16(xv[j].x, xv[j].y); w.y = cvt_pk_bf16(xv[j].z, xv[j].w); *(u32x2*)(xoutb + ro + 256 * j) = w; } }
        if (do_h) {
            const float r2 = rsqrtf(wave_sum(s2, lane) * (1.f / D_) + EPS_);
#pragma unroll
            for (int j = 0; j < 4; ++j) { const f32x4 hv = (xv[j] * r2) * gpr[j] + sh[j];
                u32x2 w; w.x = cvt_pk_bf16(hv.x, hv.y); w.y = cvt_pk_bf16(hv.z, hv.w);
                *(u32x2*)(H + ro + 256 * j) = w; }
        }
    }
}

template <int W> __device__ __forceinline__ void pool_block8(const bf16_t* P, bf16_t* ACAT, int t0, int c8) {
    const int tt0 = t0 & (L_ - 1);
    u32x4 raw[W + 7];
#pragma unroll
    for (int i = 0; i < W + 7; ++i) { raw[i] = (u32x4){0u, 0u, 0u, 0u}; if (tt0 + i - (W - 1) >= 0) raw[i] = *(const u32x4*)(P + (size_t)(t0 + i - (W - 1)) * NIN + 1024 + c8); }
    float s[8];
#pragma unroll
    for (int q = 0; q < 8; ++q) s[q] = 0.f;
#pragma unroll
    for (int i = 0; i < W - 1; ++i) { float uu[8]; unpack8(raw[i], uu);
#pragma unroll
        for (int q = 0; q < 8; ++q) s[q] += uu[q]; }
#pragma unroll
    for (int j = 0; j < 8; ++j) {
        float cur[8]; unpack8(raw[W - 1 + j], cur);
#pragma unroll
        for (int q = 0; q < 8; ++q) s[q] += cur[q];
        const int cnt = (tt0 + j + 1) < W ? (tt0 + j + 1) : W; const float inv = 1.0f / (float)cnt;
        float o[8];
#pragma unroll
        for (int q = 0; q < 8; ++q) o[q] = s[q] * inv - cur[q];
        *(u32x4*)(ACAT + (size_t)(t0 + j) * D_ + 512 + c8) = pack8(o);
        float old[8]; unpack8(raw[j], old);
#pragma unroll
        for (int q = 0; q < 8; ++q) s[q] -= old[q];
    }
}
__device__ __forceinline__ void conv_block8(const bf16_t* P, bf16_t* ACAT, const float* convw, int t0, int c8) {
    const int tt0 = t0 & (L_ - 1);
    u32x4 rc[10], rv[10], rb[8];
#pragma unroll
    for (int i = 0; i < 10; ++i) { rc[i] = (u32x4){0u, 0u, 0u, 0u}; rv[i] = rc[i]; if (tt0 + i - 2 >= 0) { const size_t ro = (size_t)(t0 + i - 2) * NIN; rc[i] = *(const u32x4*)(P + ro + 256 + c8); rv[i] = *(const u32x4*)(P + ro + 512 + c8); } }
#pragma unroll
    for (int j = 0; j < 8; ++j) rb[j] = *(const u32x4*)(P + (size_t)(t0 + j) * NIN + c8);
    float w[3][8];
#pragma unroll
    for (int k = 0; k < 3; ++k) { const f32x4 w0 = *(const f32x4*)(convw + k * 256 + c8), w1 = *(const f32x4*)(convw + k * 256 + c8 + 4);
#pragma unroll
        for (int q = 0; q < 4; ++q) { w[k][q] = w0[q]; w[k][4 + q] = w1[q]; } }
    float u0[8], u1[8], u2[8];
    { float a[8], b[8]; unpack8(rc[0], a); unpack8(rv[0], b);
#pragma unroll
      for (int q = 0; q < 8; ++q) u0[q] = a[q] * b[q];
      unpack8(rc[1], a); unpack8(rv[1], b);
#pragma unroll
      for (int q = 0; q < 8; ++q) u1[q] = a[q] * b[q]; }
#pragma unroll
    for (int j = 0; j < 8; ++j) {
        float a[8], b[8], g[8], o[8]; unpack8(rc[j + 2], a); unpack8(rv[j + 2], b); unpack8(rb[j], g);
#pragma unroll
        for (int q = 0; q < 8; ++q) { u2[q] = a[q] * b[q]; o[q] = g[q] * ((w[0][q] * u0[q] + w[1][q] * u1[q]) + w[2][q] * u2[q]); u0[q] = u1[q]; u1[q] = u2[q]; }
        *(u32x4*)(ACAT + (size_t)(t0 + j) * D_ + c8) = pack8(o);
    }
}
__device__ __forceinline__ void convpool(const bf16_t* P, bf16_t* ACAT, const float* convw  , int gt, int ngt) {
    constexpr int NI = T_ * 32 / 8;
    for (int it = gt; it < 2 * NI; it += ngt) {
        if (it < NI) { conv_block8(P, ACAT, convw, (it >> 5) * 8, (it & 31) * 8); }
        else { const int p = it - NI, gi = p >> 14, rem = p & 16383, t0 = (rem >> 3) * 8, c8 = gi * 64 + (rem & 7) * 8;
            if (gi == 0) pool_block8<2>(P, ACAT, t0, c8); else if (gi == 1) pool_block8<4>(P, ACAT, t0, c8); else if (gi == 2) pool_block8<8>(P, ACAT, t0, c8); else pool_block8<16>(P, ACAT, t0, c8); }
    }
}

__device__ __forceinline__ void s5_scan_item(const float* Z, bf16_t* ASSM, const float* APOW_l, int it, int lane) {
    const int g = it >> 3, b = it & 7, p = lane;
    const float ar = APOW_l[(((size_t)g * 64 + p) * 17 + 16) * 2], ai = APOW_l[(((size_t)g * 64 + p) * 17 + 16) * 2 + 1];
    float sr = 0.f, si = 0.f;
    const size_t row0 = (size_t)g * 1024 + b * 128;
    float zr[16], zi[16], yr[16], yi[16];
#pragma unroll
    for (int c = 0; c < 16; ++c) { const float2 z = *(const float2*)(Z + (row0 + c) * 256 + 2 * p); zr[c] = z.x; zi[c] = z.y; }
    for (int c0 = 0; c0 < 128; c0 += 16) {
        if (c0 + 16 < 128) {
#pragma unroll
            for (int c = 0; c < 16; ++c) { const float2 z = *(const float2*)(Z + (row0 + c0 + 16 + c) * 256 + 2 * p); yr[c] = z.x; yi[c] = z.y; } }
#pragma unroll
        for (int c = 0; c < 16; ++c) {
            *(unsigned*)(ASSM + (row0 + c0 + c) * 384 + 256 + 2 * p) = cvt_pk_bf16(sr, si);
            const float nr = ar * sr - ai * si + zr[c], ni = ar * si + ai * sr + zi[c]; sr = nr; si = ni; }
#pragma unroll
        for (int c = 0; c < 16; ++c) { zr[c] = yr[c]; zi[c] = yi[c]; }
    }
}

__device__ __forceinline__ void sb_attn_unit(const bf16_t* P, const bf16_t* VT, bf16_t* ACAT, int b, int hd, int qb, int lane) {
    const int r32 = lane & 31, hi = lane >> 5;
    const size_t rowbase = (size_t)b * L_;
    const bf16_t* qp = P + (rowbase + 32 * qb + r32) * NIN + 1280 + hd * 64 + 8 * hi;
    bf16x8 qf[4];
#pragma unroll
    for (int d0 = 0; d0 < 4; ++d0) qf[d0] = *(const bf16x8*)(qp + 16 * d0);
    f32x16 o0, o1;
#pragma unroll
    for (int i = 0; i < 16; ++i) { o0[i] = 0.f; o1[i] = 0.f; }
    float R = 1.f;
    for (int kt = qb; kt >= 0; --kt) {
        const bf16_t* kp = P + (rowbase + 32 * kt + r32) * NIN + 1536 + hd * 64 + 8 * hi;
        bf16x8 kf[4];
#pragma unroll
        for (int d0 = 0; d0 < 4; ++d0) kf[d0] = *(const bf16x8*)(kp + 16 * d0);
        const bf16_t* vp = VT + (size_t)(hd * 64 + r32) * T_ + rowbase + 32 * kt + 4 * hi;
        s16x4 va[2][2][2];
#pragma unroll
        for (int db = 0; db < 2; ++db)
#pragma unroll
            for (int s2 = 0; s2 < 2; ++s2) { va[db][s2][0] = *(const s16x4*)(vp + (size_t)db * 32 * T_ + 16 * s2); va[db][s2][1] = *(const s16x4*)(vp + (size_t)db * 32 * T_ + 16 * s2 + 8); }
        f32x16 s;
#pragma unroll
        for (int i = 0; i < 16; ++i) s[i] = 0.f;
#pragma unroll
        for (int d0 = 0; d0 < 4; ++d0) s = __builtin_amdgcn_mfma_f32_32x32x16_bf16(kf[d0], qf[d0], s, 0, 0, 0);
        float sg[16], kq[16];
        const bool diag = (kt == qb);
#pragma unroll
        for (int i = 0; i < 16; ++i) {
            const float z = s[i];
            const float e = __expf(-fmaxf(z, -80.f));
            const float r = __builtin_amdgcn_rcpf(1.0f + e);
            const bool valid = !diag || ((8 * (i >> 2) + 4 * hi + (i & 3)) < r32);
            sg[i] = valid ? r : 0.f;
            kq[i] = valid ? e * r : 1.f;
        }
        float G[4], Gp[4];
#pragma unroll
        for (int g = 0; g < 4; ++g) { G[g] = (kq[4 * g] * kq[4 * g + 1]) * (kq[4 * g + 2] * kq[4 * g + 3]); Gp[g] = shfl_xor_(G[g], 32, lane); }
        float run = R; float aft[4];
#pragma unroll
        for (int g = 3; g >= 0; --g) { aft[g] = hi == 0 ? run * Gp[g] : run; run *= G[g] * Gp[g]; }
        float pa[16];
#pragma unroll
        for (int g = 0; g < 4; ++g) { float sfx = aft[g];
#pragma unroll
            for (int j = 3; j >= 0; --j) { pa[4 * g + j] = sg[4 * g + j] * sfx; sfx *= kq[4 * g + j]; } }
        R = run;
        bf16x8 pf[2];
#pragma unroll
        for (int s2 = 0; s2 < 2; ++s2) { u32x4 w; w.x = cvt_pk_bf16(pa[8 * s2], pa[8 * s2 + 1]); w.y = cvt_pk_bf16(pa[8 * s2 + 2], pa[8 * s2 + 3]); w.z = cvt_pk_bf16(pa[8 * s2 + 4], pa[8 * s2 + 5]); w.w = cvt_pk_bf16(pa[8 * s2 + 6], pa[8 * s2 + 7]);
            pf[s2] = __builtin_bit_cast(bf16x8, w); }
#pragma unroll
        for (int s2 = 0; s2 < 2; ++s2) {
            const bf16x8 v0 = (bf16x8){va[0][s2][0][0], va[0][s2][0][1], va[0][s2][0][2], va[0][s2][0][3], va[0][s2][1][0], va[0][s2][1][1], va[0][s2][1][2], va[0][s2][1][3]};
            const bf16x8 v1 = (bf16x8){va[1][s2][0][0], va[1][s2][0][1], va[1][s2][0][2], va[1][s2][0][3], va[1][s2][1][0], va[1][s2][1][1], va[1][s2][1][2], va[1][s2][1][3]};
            o0 = __builtin_amdgcn_mfma_f32_32x32x16_bf16(v0, pf[s2], o0, 0, 0, 0);
            o1 = __builtin_amdgcn_mfma_f32_32x32x16_bf16(v1, pf[s2], o1, 0, 0, 0);
        }
#if SB_EARLY_EXIT
        if (__all(R < 1.0e-37f)) break;
#endif
    }
    bf16_t* op = ACAT + (rowbase + 32 * qb + r32) * D_ + 768 + hd * 64 + 4 * hi;
#pragma unroll
    for (int g = 0; g < 4; ++g) {
        u32x2 w0; w0.x = cvt_pk_bf16(o0[4 * g], o0[4 * g + 1]); w0.y = cvt_pk_bf16(o0[4 * g + 2], o0[4 * g + 3]);
        u32x2 w1; w1.x = cvt_pk_bf16(o1[4 * g], o1[4 * g + 1]); w1.y = cvt_pk_bf16(o1[4 * g + 2], o1[4 * g + 3]);
        *(u32x2*)(op + 8 * g) = w0; *(u32x2*)(op + 32 + 8 * g) = w1; }
}


__device__ __forceinline__ bool bm_next(const pg8::GOrder& S, int i, int& pm, int& pnh, int& sel) {
    const int ii = i / 10, rem = i - 10 * ii, hh = rem / 5; sel = rem - 5 * hh;
    pg8::Unit u; if (!S.next(ii, u)) return false;
    pm = u.pm; pnh = 2 * u.pn + hh; return true;
}
__device__ __forceinline__ void branch_merge_phase(LAS unsigned char* lds, unsigned char* ws, const unsigned char* wl, int G, int bid, const int tid) {
    using namespace pg8;
    const int wid = __builtin_amdgcn_readfirstlane(tid >> 6), lane = tid & 63, wr = wid >> 2, wc = wid & 3, fr = lane & 15, fq = lane >> 4;
    constexpr int lda = D_, ldb = 256;
    unsigned voffA[2], voffB[2];
#pragma unroll
    for (int i = 0; i < 2; ++i) { int R, C; stage_rc(tid * 16 + i * 8192, R, C); const int Rb = (R & ~31) + perm32(R & 31);
        voffA[i] = (unsigned)(R * lda + C) * 2u; voffB[i] = (unsigned)(Rb * ldb + C) * 2u; }
    const size_t kstep = (size_t)(BK * 2), hsA = (size_t)HALF * lda * 2;
    const unsigned ldsw = (unsigned)wid * 1024u;
    const int aoff = lds_byte(wr * 64 + fr, fq * 8), boff = lds_byte(wc * 32 + fr, fq * 8);
#define BM_SA(b, h) (((b) * 2 + (h)) * HTB)
#define BM_SB(b) ((4 + (b) * 2) * HTB)
#define BM_STAGE(bufoff, gbase, voff) do { _Pragma("unroll") for (int _i = 0; _i < 2; ++_i) \
        __builtin_amdgcn_global_load_lds((const unsigned*)((const char*)(gbase) + (voff)[_i]), (LAS unsigned*)(lds + (bufoff) + ldsw + _i * 8192), 16, 0, 0); } while (0)
#define BM_LDA(dst, b, h) do { _Pragma("unroll") for (int m = 0; m < 4; ++m) _Pragma("unroll") for (int k = 0; k < 2; ++k) dst[m][k] = *(const LAS bf16x8*)(lds + BM_SA(b, h) + aoff + m * 2048 + k * 1024); } while (0)
#define BM_LDB(dst, b) do { _Pragma("unroll") for (int n = 0; n < 2; ++n) _Pragma("unroll") for (int k = 0; k < 2; ++k) dst[n][k] = *(const LAS bf16x8*)(lds + BM_SB(b) + boff + n * 2048 + k * 1024); } while (0)
#define BM_MMA(ai, At, Bt) do { __builtin_amdgcn_s_setprio(1); _Pragma("unroll") for (int m = 0; m < 4; ++m) _Pragma("unroll") for (int n = 0; n < 2; ++n) _Pragma("unroll") for (int k = 0; k < 2; ++k) \
        acc[ai][m][n] = __builtin_amdgcn_mfma_f32_16x16x32_bf16(Bt[n][k], At[m][k], acc[ai][m][n], 0, 0, 0); __builtin_amdgcn_s_setprio(0); } while (0)
#define BM_WAIT_V(n) asm volatile("s_waitcnt vmcnt(" #n ")" ::: "memory")
#define BM_WAIT_L(n) asm volatile("s_waitcnt lgkmcnt(" #n ")" ::: "memory")
#define BM_BAR __builtin_amdgcn_s_barrier()
#define BM_SCHED __builtin_amdgcn_sched_barrier(0)
#define BM_PTRS(pm_, pnh_, sel_, pa_, pb_) do { \
        pa_ = (const char*)(ws + WS_ACAT) + ((size_t)(pm_) * 256 * lda + ((sel_) == 0 ? 0 : ((sel_) == 1 ? 512 : ((sel_) == 2 ? 768 : 256)))) * 2; \
        pb_ = (const char*)wl + ((sel_) == 0 ? OFF_WCONV : ((sel_) == 1 ? OFF_WPOOL : ((sel_) == 2 ? OFF_WSB : OFF_WGLU))) \
              + (size_t)((sel_) < 3 ? (pnh_) * 128 : (pnh_) * 256 + ((sel_) == 4 ? 128 : 0)) * ldb * 2; } while (0)
    GOrder S; S.init(T_, D_, G, bid);
    int ui = 0, pm, pnh, sel, npm, npnh, nsel;
    if (!bm_next(S, 0, pm, pnh, sel)) return;
    f32x4 acc[2][4][2], macc[2][4][2]; u32x2 tmpb[2][4][2];
#pragma unroll
    for (int a = 0; a < 2; ++a)
#pragma unroll
        for (int m = 0; m < 4; ++m)
#pragma unroll
            for (int n = 0; n < 2; ++n) { acc[a][m][n] = (f32x4){0.f, 0.f, 0.f, 0.f}; macc[a][m][n] = (f32x4){0.f, 0.f, 0.f, 0.f}; tmpb[a][m][n] = (u32x2){0u, 0u}; }
    bf16x8 At[4][2], B0[2][2];
    const char* cA; const char* cB; BM_PTRS(pm, pnh, sel, cA, cB);
    BM_STAGE(BM_SB(0), cB, voffB); BM_STAGE(BM_SA(0, 0), cA, voffA); BM_STAGE(BM_SA(0, 1), cA + hsA, voffA);
    if (wr == 1) BM_BAR;
    BM_WAIT_V(2); BM_BAR;
    BM_STAGE(BM_SB(1), cB + kstep, voffB); BM_STAGE(BM_SA(1, 0), cA + kstep, voffA);
    BM_WAIT_V(4); BM_BAR;
    const bf16_t* Pg = (const bf16_t*)(ws + WS_P); bf16_t* Hm = (bf16_t*)(ws + WS_H);
    for (;;) {
        const bool has_next = bm_next(S, ui + 1, npm, npnh, nsel);
        const char* nA = cA; const char* nB = cB; if (has_next) BM_PTRS(npm, npnh, nsel, nA, nB);
#pragma unroll 1
        for (int t = 0; t < 4; t += 2) {
            const bool last = (t == 2);
            const char* a1 = cA + (size_t)(t + 1) * kstep;
            const char* a2 = last ? nA : cA + (size_t)(t + 2) * kstep; const char* b2 = last ? nB : cB + (size_t)(t + 2) * kstep;
            const char* a3 = a2 + kstep; const char* b3 = b2 + kstep;
            BM_LDB(B0, 0); BM_SCHED; BM_LDA(At, 0, 0); BM_STAGE(BM_SA(1, 1), a1 + hsA, voffA);
            BM_WAIT_V(6); BM_WAIT_L(0); BM_BAR; BM_MMA(0, At, B0); BM_BAR; BM_SCHED;
            BM_LDA(At, 0, 1); BM_STAGE(BM_SB(0), b2, voffB); BM_STAGE(BM_SA(0, 0), a2, voffA);
            BM_WAIT_V(6); BM_WAIT_L(0); BM_BAR; BM_MMA(1, At, B0); BM_BAR; BM_SCHED;
            BM_LDB(B0, 1); BM_SCHED; BM_LDA(At, 1, 0); BM_STAGE(BM_SA(0, 1), a2 + hsA, voffA);
            BM_WAIT_V(6); BM_WAIT_L(0); BM_BAR; BM_MMA(0, At, B0); BM_BAR; BM_SCHED;
            BM_LDA(At, 1, 1); BM_STAGE(BM_SB(1), b3, voffB); BM_STAGE(BM_SA(1, 0), a3, voffA);
            BM_WAIT_V(6); BM_WAIT_L(0); BM_BAR; BM_MMA(1, At, B0); BM_BAR; BM_SCHED;
        }
        if (wr == 0) BM_BAR;
        {
            const int row0 = pm * 256 + wr * 64 + fr, col = pnh * 128 + wc * 32 + 8 * fq;
            const int gcol = sel == 0 ? 2048 : (sel == 1 ? 4096 : (sel == 2 ? 5120 : 3072));
#pragma unroll
            for (int ai = 0; ai < 2; ++ai)
#pragma unroll
                for (int m = 0; m < 4; ++m) { const int r = row0 + ai * HALF + m * 16;
                    if (sel == 3) {
#pragma unroll
                        for (int n = 0; n < 2; ++n) { tmpb[ai][m][n].x = cvt_pk_bf16(acc[ai][m][n][0], acc[ai][m][n][1]); tmpb[ai][m][n].y = cvt_pk_bf16(acc[ai][m][n][2], acc[ai][m][n][3]); }
                    } else {
                        float gt[8]; unpack8(*(const u32x4*)(Pg + (size_t)r * NIN + gcol + col), gt);
#pragma unroll
                        for (int q = 0; q < 8; ++q) gt[q] = sigmoidf_(gt[q]);
#pragma unroll
                        for (int n = 0; n < 2; ++n)
#pragma unroll
                            for (int i = 0; i < 4; ++i) {
                                float y = acc[ai][m][n][i];
                                if (sel == 4) { const unsigned tw = i < 2 ? tmpb[ai][m][n].x : tmpb[ai][m][n].y; y = ((i & 1) ? bf_hi(tw) : bf_lo(tw)) * sigmoidf_(y); }
                                const float v = gt[4 * n + i] * y;
                                macc[ai][m][n][i] = sel == 0 ? v : macc[ai][m][n][i] + v; }
                        if (sel == 4) { float v[8];
#pragma unroll
                            for (int n = 0; n < 2; ++n)
#pragma unroll
                                for (int i = 0; i < 4; ++i) v[4 * n + i] = macc[ai][m][n][i];
                            *(u32x4*)(Hm + (size_t)r * D_ + col) = pack8(v); }
                    } }
        }
        if (!has_next) break;
#pragma unroll
        for (int a = 0; a < 2; ++a)
#pragma unroll
            for (int m = 0; m < 4; ++m)
#pragma unroll
                for (int n = 0; n < 2; ++n) acc[a][m][n] = (f32x4){0.f, 0.f, 0.f, 0.f};
        pm = npm; pnh = npnh; sel = nsel; cA = nA; cB = nB; ++ui;
        if (wr == 1) BM_BAR;
    }
    BM_WAIT_V(0);
    BM_BAR;
#undef BM_SA
#undef BM_SB
#undef BM_STAGE
#undef BM_LDA
#undef BM_LDB
#undef BM_MMA
#undef BM_WAIT_V
#undef BM_WAIT_L
#undef BM_BAR
#undef BM_SCHED
#undef BM_PTRS
}

__global__ void __launch_bounds__(512, 2) mega(Args args) {
    extern __shared__ __attribute__((aligned(16))) unsigned char smem[];
    LAS unsigned char* lds = (LAS unsigned char*)smem;
    const int G = gridDim.x; int bid = blockIdx.x;
    const int ngw = G * 8, ngt = G * 512;
    LAS unsigned long long* tab = (LAS unsigned long long*)(lds + 131072);
    volatile LAS unsigned* bst = (volatile LAS unsigned*)(lds + 131072 + 512);
    if (threadIdx.x == 0) { bst[0] = 0u; bst[1] = 0u; }
    __syncthreads();
    (void)xcd_barrier_post((unsigned*)(args.ws + WS_BAR), bst);
    if (threadIdx.x == 0) { const unsigned xcc = xb_xcc_id(); bst[2] = xcc; bst[3] = xb_add((unsigned*)(args.ws + WS_BAR) + XCD_BAR_WORDS + 64 * (xcc & 7u), 1u); }
    if (threadIdx.x == 0) {
#pragma unroll
        for (int i = 0; i < 25; ++i) tab[i] = (unsigned long long)args.in[i];
    }
    __syncthreads();
    Ctx a; a.tab = tab; a.ws = (unsigned char*)(GAS unsigned char*)(unsigned long long)args.ws;
    for (int ph = args.ph_lo; ph < args.ph_hi; ++ph) {
        if (args.coop && ph == args.ph_lo + 1) {
            if (threadIdx.x == 0) { unsigned* bar = (unsigned*)(args.ws + WS_BAR); bool ok = (G % 8) == 0;
                for (unsigned j = 0; j < 16; ++j) { const unsigned c = xb_ld(&bar[XB_XCNT(j)]); ok = ok && (c == (j < 8 ? (unsigned)(G / 8) : 0u)); }
                const unsigned cv = bst[3] * 8u + bst[2]; bst[4] = (ok && cv < (unsigned)G) ? cv : (unsigned)blockIdx.x; }
            __syncthreads();
            bid = (int)__builtin_amdgcn_readfirstlane(bst[4]);
        }
#define LOCAL_IDS() int tid = threadIdx.x; asm volatile("" : "+v"(tid)); const int lane = tid & 63, wave = __builtin_amdgcn_readfirstlane(tid >> 6); \
        const int gw = bid * 8 + wave, gt = bid * 512 + tid; (void)lane; (void)gw; (void)gt;
        unsigned long long wsi = (unsigned long long)args.ws; asm volatile("" : "+s"(wsi));
        unsigned char* ws = (unsigned char*)(GAS unsigned char*)wsi;
        float* X = args.out;
        float* ADA = (float*)(ws + WS_ADA);
        bf16_t* H = (bf16_t*)(ws + WS_H); bf16_t* P = (bf16_t*)(ws + WS_P); float* F = (float*)(ws + WS_F);
        bf16_t* ACAT = (bf16_t*)(ws + WS_ACAT); bf16_t* ASSM = (bf16_t*)(ws + WS_ASSM); float* Z = (float*)(ws + WS_Z); bf16_t* VT = (bf16_t*)(ws + WS_VT);
        if (ph >= 1000) {
            LOCAL_IDS();
            for (size_t i = gt; i < (size_t)T_ * D_; i += ngt) { float v = 0.f;
                if (ph == 1000) { v = bf_lo(ACAT[i]); if (!((MK_DUMP_MASK >> ((i & 1023) >> 8)) & 1)) v = 0.f; }
                else if (ph == 1001) v = F[i];
                else if (ph == 1002) v = bf_lo(H[i]);
                else if (ph == 1003) v = i < (size_t)256 * T_ ? bf_lo(VT[i]) : 0.f;
                else if (ph == 1004) { const size_t t = i >> 10, c = i & 1023; v = c < 512 ? bf_lo(P[t * NIN + 1280 + c]) : 0.f; }
                X[i] = v; }
        } else if (ph == 0) {
            LOCAL_IDS();
            p0_ada(a, (LAS float*)lds, tid, lane, wave, bid, G);
            p0_tables(a, gt, ngt);
            LAS float* scr = (LAS float*)(lds + wave * 16384);
            for (int it = gw; it < DEPTH * IT_POOL; it += ngw) p0_pool_item(a, it, lane);
            p0_transposes(a, gw, ngw, scr, lane);
        } else if (ph == 1) {
            LOCAL_IDS();
            if (T_ == 8 * ngw) rowop_c(a.in(0), nullptr, nullptr, (bf16_t*)(ws + WS_XB), nullptr, 0.f, nullptr, nullptr, true, ADA, a.in(4), H, gw, lane);
            else rowop(a.in(0), nullptr, nullptr, (bf16_t*)(ws + WS_XB), nullptr, 0.f, nullptr, nullptr, true, ADA, a.in(4), H, gw, ngw, lane);
            p1_kern(a, gt, ngt);
        } else {
            const int l = (ph - 2) / 11, st = (ph - 2) % 11;
            unsigned char* wl = ws + WS_W + (size_t)l * LAYER_W;
            const float* ada_l = ADA + (size_t)l * 8 * 9216;
            if (st == 2 || st == 7 || st == 10) {
                LOCAL_IDS();
                const int sub = st == 2 ? 0 : (st == 7 ? 1 : 2);
                const float resw = sub == 1 ? 1.0f : 0.5f;
                const bool last = (st == 10 && l == DEPTH - 1);
                const int nl = st == 10 ? l + 1 : l, nsub = st == 10 ? 0 : sub + 1;
                const float* ada_n = ADA + (size_t)(last ? l : nl) * 8 * 9216 + nsub * 3072;
                const float* gpre = a.in(4) + (size_t)((last ? l : nl) * 3 + nsub) * D_;
                if (T_ == 8 * ngw)
                    rowop_c(nullptr, (const bf16_t*)(ws + WS_XB), last ? X : nullptr, (bf16_t*)(ws + WS_XB), (const bf16_t*)F, resw, ada_l + sub * 3072 + 2048, a.in(5) + (size_t)(l * 3 + sub) * D_, !last, ada_n, gpre, H, gw, lane);
                else
                    rowop(nullptr, (const bf16_t*)(ws + WS_XB), last ? X : nullptr, (bf16_t*)(ws + WS_XB), (const bf16_t*)F, resw, ada_l + sub * 3072 + 2048, a.in(5) + (size_t)(l * 3 + sub) * D_, !last, ada_n, gpre, H, gw, ngw, lane);
            } else {
                if (st == 5) { int tidg = threadIdx.x; asm volatile("" : "+v"(tidg)); branch_merge_phase(lds, ws, wl, G, bid, tidg); }
                const int ng = st == 5 ? 0 : ((st == 3 || st == 4) ? 2 : 1);
                for (int gi = 0; gi < ng; ++gi) {
                    pg8::Gemm g; pg8::GOrder S; pg8::GEpi E;
                    g.bshift = 0; g.bgs = 0;
                    E.mode_ = pg8::EM_FB16; E.gcol_ = 0; E.ws = ws; E.dskip = nullptr;
                    if (st == 0 || st == 8) {
                        g.A = H; g.Bt = (const bf16_t*)(wl + OFF_FFIN0 + (st == 8 ? SZ_FFIN : 0)); g.K = D_; g.lda = D_; g.ldb = D_;
                        S.init(T_, 2 * FF_, G, bid); E.mode_ = pg8::EM_SWIGLU;
                    } else if (st == 1 || st == 9) {
                        g.A = P; g.Bt = (const bf16_t*)(wl + OFF_FFOUT0 + (st == 9 ? SZ_FFOUT : 0)); g.K = FF_; g.lda = FF_; g.ldb = FF_;
                        S.init(T_, D_, G, bid);
                    } else if (st == 3 && gi == 0) {
                        g.A = H; g.Bt = (const bf16_t*)(wl + OFF_WIN); g.K = D_; g.lda = D_; g.ldb = D_;
                        S.init(T_, NIN - 256, G, bid); S.skip = 7; E.mode_ = pg8::EM_MIXIN;
                    } else if (st == 3) {
                        g.A = (const bf16_t*)(wl + OFF_WIN) + (size_t)7 * 256 * D_; g.Bt = H; g.K = D_; g.lda = D_; g.ldb = D_;
                        const int rem = (64 * 23) % G;
                        S.init(256, T_, G, (bid - rem + G) % G); E.mode_ = pg8::EM_BF16;
                    } else if (st == 4 && gi == 0) {
                        g.A = ASSM; g.Bt = (const bf16_t*)(wl + OFF_WZ); g.K = 256; g.lda = 384; g.ldb = 256; g.bshift = 2; g.bgs = (size_t)256 * 256;
                        S.init(16384, 256, G, bid); E.mode_ = pg8::EM_F32Z;
                    } else if (st == 4) {
                        g.A = ASSM; g.Bt = (const bf16_t*)(wl + OFF_TM); g.K = 384; g.lda = 384; g.ldb = 384; g.bshift = 2; g.bgs = (size_t)256 * 384;
                        S.init(16384, 256, G, bid); E.mode_ = pg8::EM_S5Y; E.dskip = a.in(18) + (size_t)l * 256;
                    } else if (st == 5) {
                        g.A = ACAT; g.Bt = (const bf16_t*)(wl + OFF_WCONV); g.K = 256; g.lda = D_; g.ldb = 256;
                        S.init(T_, D_, G, bid); S.branch = 1; E.mode_ = pg8::EM_BRANCH;
                    } else {
                        g.A = H; g.Bt = (const bf16_t*)(wl + OFF_WOUT); g.K = D_; g.lda = D_; g.ldb = D_;
                        S.init(T_, D_, G, bid);
                    }
                    { int tidg = threadIdx.x; asm volatile("" : "+v"(tidg)); pg8::gemm_phase<pg8::GEpi, pg8::GOrder, true>(lds, g, S, E, tidg); }
                    if (ph == 2) {
                        LOCAL_IDS();
                        constexpr int NU = (T_ / 256) * (2 * FF_ / 256);
                        const int full = (NU + G - 1) / G; int first_idle = NU - (full - 1) * G; if (first_idle >= G) first_idle = 0;
                        if (bid >= first_idle) p2_fill(a, (bid - first_idle) * 512 + tid, (G - first_idle) * 512);
                    }
                    if (st == 4 && gi == 0) {
                        LOCAL_IDS();
                        const float* APOW_l = (const float*)(ws + WS_APOW) + (size_t)l * 16 * 64 * 17 * 2;
                        pg8::Unit u;
                        for (int i = 0; S.next(i, u); ++i) { const int it = (u.pm >> 2) * 8 + 2 * (u.pm & 3) + ((wave + 2 * i) & 1); if (((wave + 2 * i) & 7) < 2) s5_scan_item(Z, ASSM, APOW_l, it, lane); }
                        asm volatile("s_waitcnt vmcnt(0)" ::: "memory");
                        __syncthreads();
                    }
                }
                if (st == 4) {
                    LOCAL_IDS();
                    const int afirst = G > 64 ? 64 : 0, nslots = (G - afirst) * 8;
                    if (bid >= afirst) convpool(P, ACAT, a.in(9) + (size_t)l * 3 * 256, (bid - afirst) * 512 + tid, (G - afirst) * 512);
                    if (bid >= afirst)
                        for (int u = (bid - afirst) * 8 + wave; u < NB * 4 * 64; u += nslots) { const int qb = 63 - (u & 63), bh = u >> 6; sb_attn_unit(P, VT, ACAT, bh >> 2, bh & 3, qb, lane); }
                }
            }
        }
        if (ph + 1 < args.ph_hi && args.coop) {
            if (args.coop < 0) cg::this_grid().sync();
            { XcdBarrier xb; xb.bar = (unsigned*)(args.ws + WS_BAR); xb.x = xb_xcc_id(); xb.st = bst; xcd_barrier(xb); }
        }
    }
}

extern "C" void kernel_launch(void* const* d_in, const int* in_sizes, int n_in, void* d_out, int out_size, void* d_ws, size_t ws_size, hipStream_t stream) {
    static int grid = 0;
    if (grid == 0) {
        if (n_in != 25 || out_size != T_ * D_ || ws_size < WS_END) { fprintf(stderr, "kernel_launch: unexpected shapes: n_in %d out %d ws %zu (need %zu)\n", n_in, out_size, ws_size, (size_t)WS_END); grid = -1; return; }
        int dev = 0, cus = 0, per_cu = 0;
        (void)hipGetDevice(&dev);
        (void)hipDeviceGetAttribute(&cus, hipDeviceAttributeMultiprocessorCount, dev);
        if (hipFuncSetAttribute((const void*)mega, hipFuncAttributeMaxDynamicSharedMemorySize, LDS_BYTES) != hipSuccess) { fprintf(stderr, "kernel_launch: hipFuncSetAttribute failed\n"); grid = -1; return; }
        (void)hipOccupancyMaxActiveBlocksPerMultiprocessor(&per_cu, (const void*)mega, 512, LDS_BYTES);
        if (per_cu < 1) { fprintf(stderr, "kernel_launch: occupancy query says %d blocks per CU\n", per_cu); per_cu = 1; }
        (void)hipGetLastError();
        grid = cus * per_cu;
        if (grid > 256) grid = 256;
        fprintf(stderr, "kernel_launch: grid %d (cus %d, per_cu %d), ws need %zu MiB of %zu MiB\n", grid, cus, per_cu, (size_t)(WS_END >> 20), ws_size >> 20);
    }
    if (grid < 0) return;
    Args a{};
    for (int i = 0; i < 25; ++i) a.in[i] = (const float*)d_in[i];
    a.out = (float*)d_out; a.ws = (unsigned char*)d_ws;
#if MK_PER_PHASE
    for (int ph = 0; ph < NPHASE; ++ph) { a.ph_lo = ph; a.ph_hi = ph + 1; a.coop = 0; hipLaunchKernelGGL(mega, dim3(grid), dim3(512), LDS_BYTES, stream, a); }
#ifdef MK_DUMP
    a.ph_lo = MK_DUMP; a.ph_hi = MK_DUMP + 1; a.coop = 0; hipLaunchKernelGGL(mega, dim3(grid), dim3(512), LDS_BYTES, stream, a);
#endif
#else
    (void)hipMemsetAsync((char*)d_ws + WS_BAR, 0, BAR_BYTES, stream);
    a.ph_lo = 0; a.ph_hi = NPHASE; a.coop = 1;
    void* args[] = {&a};
    hipError_t e = hipLaunchCooperativeKernel((const void*)mega, dim3(grid), dim3(512), args, LDS_BYTES, stream);
    if (e != hipSuccess) fprintf(stderr, "kernel_launch: cooperative launch failed: %s (grid %d)\n", hipGetErrorString(e), grid);
#endif
}
```

```cpp
#include <hip/hip_runtime.h>
#include <hip/hip_cooperative_groups.h>
#include <cstdio>
#include <cstdint>
namespace cg = cooperative_groups;

#ifndef MK_PER_PHASE
#define MK_PER_PHASE 0
#endif
#ifndef PROBE_SYNC2
#define PROBE_SYNC2 0
#endif
#ifndef SB_EARLY_EXIT
#define SB_EARLY_EXIT 1
#endif

#define LAS __attribute__((address_space(3)))
#define GAS __attribute__((address_space(1)))
typedef unsigned short bf16_t;
typedef short bf16x8 __attribute__((ext_vector_type(8)));
typedef short s16x4 __attribute__((ext_vector_type(4)));
typedef float f32x4 __attribute__((ext_vector_type(4)));
typedef float f32x16 __attribute__((ext_vector_type(16)));
typedef unsigned u32x4 __attribute__((ext_vector_type(4)));
typedef unsigned u32x2 __attribute__((ext_vector_type(2)));

constexpr int T_ = 16384, D_ = 1024, L_ = 2048, NB = 8, FF_ = 2816, NIN = 6144, DEPTH = 4;
constexpr float EPS_ = 1e-6f;
#ifndef MK_STOP_PH
#define MK_STOP_PH (2 + 11 * DEPTH)
#define MK_DUMP_MASK 15
#endif
constexpr int NPHASE = MK_STOP_PH;

constexpr size_t SZ_FFIN = (size_t)2 * FF_ * D_ * 2, SZ_FFOUT = (size_t)D_ * FF_ * 2, SZ_WIN = (size_t)NIN * D_ * 2;
constexpr size_t SZ_BR = (size_t)D_ * 256 * 2, SZ_GLU = (size_t)2048 * 256 * 2, SZ_WOUT = (size_t)D_ * D_ * 2;
constexpr size_t SZ_TM = (size_t)16 * 256 * 384 * 2, SZ_WZ = (size_t)16 * 256 * 256 * 2;
constexpr size_t OFF_FFIN0 = 0, OFF_FFIN1 = OFF_FFIN0 + SZ_FFIN, OFF_FFOUT0 = OFF_FFIN1 + SZ_FFIN, OFF_FFOUT1 = OFF_FFOUT0 + SZ_FFOUT;
constexpr size_t OFF_WIN = OFF_FFOUT1 + SZ_FFOUT, OFF_WCONV = OFF_WIN + SZ_WIN, OFF_WPOOL = OFF_WCONV + SZ_BR, OFF_WSB = OFF_WPOOL + SZ_BR;
constexpr size_t OFF_WGLU = OFF_WSB + SZ_BR, OFF_WOUT = OFF_WGLU + SZ_GLU, OFF_TM = OFF_WOUT + SZ_WOUT, OFF_WZ = OFF_TM + SZ_TM;
constexpr size_t LAYER_W = OFF_WZ + SZ_WZ;
constexpr size_t MiB = 1u << 20;
constexpr size_t WS_W = 0;
constexpr size_t WS_ADA = ((DEPTH * LAYER_W + MiB - 1) / MiB) * MiB;
constexpr size_t WS_APOW = WS_ADA + 2 * MiB;
constexpr size_t WS_BB = WS_APOW + 1 * MiB;
constexpr size_t WS_KERN = WS_BB + 1 * MiB;
constexpr size_t WS_H = WS_KERN + 2 * MiB;
constexpr size_t WS_P = WS_H + (size_t)T_ * D_ * 2;
constexpr size_t WS_F = WS_P + (size_t)T_ * NIN * 2;
constexpr size_t WS_ACAT = WS_F + (size_t)T_ * D_ * 4;
constexpr size_t WS_ASSM = WS_ACAT + (size_t)T_ * D_ * 2;
constexpr size_t WS_Z = WS_ASSM + (size_t)16384 * 384 * 2;
constexpr size_t WS_VT = WS_Z + (size_t)16384 * 256 * 4;
constexpr size_t WS_XB = WS_VT + (size_t)256 * T_ * 2;
constexpr size_t WS_BAR = WS_XB + (size_t)T_ * D_ * 2;
constexpr size_t BAR_BYTES = 16384;
constexpr size_t WS_END = WS_BAR + BAR_BYTES;

constexpr int LDS_BYTES = 131072 + 1024;

typedef float f32x2_t __attribute__((ext_vector_type(2))); typedef __bf16 bf16x2_t __attribute__((ext_vector_type(2)));
__device__ __forceinline__ unsigned cvt_pk_bf16(float lo, float hi) { f32x2_t v = {lo, hi}; bf16x2_t b = __builtin_convertvector(v, bf16x2_t); return __builtin_bit_cast(unsigned, b); }
__device__ __forceinline__ float bf_lo(unsigned u) { return __uint_as_float(u << 16); }
__device__ __forceinline__ float bf_hi(unsigned u) { return __uint_as_float(u & 0xffff0000u); }
__device__ __forceinline__ float sigmoidf_(float x) { return __builtin_amdgcn_rcpf(1.0f + __expf(-x)); }
__device__ __forceinline__ float shfl_xor_(float v, int m, int lane) { return __int_as_float(__builtin_amdgcn_ds_bpermute((lane ^ m) << 2, __float_as_int(v))); }
__device__ __forceinline__ float wave_sum(float v, int lane) {
#pragma unroll
    for (int o = 1; o < 64; o <<= 1) v += shfl_xor_(v, o, lane);
    return v;
}
__device__ __forceinline__ void unpack8(u32x4 w, float* o) { o[0] = bf_lo(w.x); o[1] = bf_hi(w.x); o[2] = bf_lo(w.y); o[3] = bf_hi(w.y); o[4] = bf_lo(w.z); o[5] = bf_hi(w.z); o[6] = bf_lo(w.w); o[7] = bf_hi(w.w); }
__device__ __forceinline__ u32x4 pack8(const float* v) { u32x4 w; w.x = cvt_pk_bf16(v[0], v[1]); w.y = cvt_pk_bf16(v[2], v[3]); w.z = cvt_pk_bf16(v[4], v[5]); w.w = cvt_pk_bf16(v[6], v[7]); return w; }

namespace pg8 {
constexpr int BM = 256, BK = 64, HALF = 128, HTB = HALF * BK * 2, STAGE_BYTES = 8 * HTB, NXCD = 8, WGM = 8;
__host__ __device__ __forceinline__ int lds_byte(int r, int c) { const int st = (r >> 4) * 2 + (c >> 5), rr = r & 15, cc = c & 31, ob = rr * 64 + cc * 2; return st * 1024 + (ob ^ (((ob >> 9) & 1) << 5)); }
__host__ __device__ __forceinline__ void stage_rc(int b, int& R, int& C) { const int st = b / 1024, sb = b % 1024, swz = sb ^ (((sb >> 9) & 1) << 5); R = (st >> 1) * 16 + swz / 64; C = (st & 1) * 32 + (swz % 64) / 2; }
__host__ __device__ __forceinline__ int perm32(int rho) { const int n = rho >> 4, i = rho & 15; return 8 * (i >> 2) + 4 * n + (i & 3); }

struct Unit { int pm, pn, sel; };
struct Gemm { const bf16_t* A; const bf16_t* Bt; int K, lda, ldb, bshift; size_t bgs; };

struct GOrder {
    int nM, nN, nwg, G, c, skip, pair, branch;
    __device__ void init(int M, int N, int G_, int c_) { nM = M / BM; nN = N / BM; nwg = nM * nN; G = G_; c = c_; skip = -1; pair = 0; branch = 0; }
    __device__ bool next(int i, Unit& u) const {
        const int ii = branch ? (i / 5) : (pair ? (i >> 1) : i);
        const long L = (long)ii * G + c; if (L >= nwg) return false;
        int wgid = (int)L; { const int q = nwg / NXCD, r = nwg % NXCD, xcd = wgid % NXCD, off = wgid / NXCD; wgid = (xcd < r ? xcd * (q + 1) : r * (q + 1) + (xcd - r) * q) + off; }
        const int nig = WGM * nN, gid = wgid / nig, fm = gid * WGM, gsz = (nM - fm) < WGM ? (nM - fm) : WGM;
        u.pm = fm + ((wgid % nig) % gsz); u.pn = (wgid % nig) / gsz; u.sel = 0;
        if (skip >= 0 && u.pn >= skip) u.pn++;
        if (pair) u.pn = 2 * u.pn + (i & 1);
        if (branch) { u.sel = i - 5 * ii; if (u.sel >= 3) u.pn = 2 * u.pn + (u.sel - 3); }
        return true;
    }
    __device__ __forceinline__ size_t aoff(const Unit& u) const { return branch ? (u.sel == 0 ? 0u : (u.sel == 1 ? 1024u : (u.sel == 2 ? 1536u : 512u))) : 0u; }
    __device__ __forceinline__ size_t boff(const Unit& u) const { return branch ? (size_t)(u.sel < 3 ? u.sel : 3) * SZ_BR : 0u; }
};

template <class Epi, class Sched, bool ALIGN_EPI>
__device__ __forceinline__ void gemm_phase(LAS unsigned char* lds, const Gemm g, const Sched& S, const Epi& E, const int tid) {
    const int wid = __builtin_amdgcn_readfirstlane(tid >> 6), lane = tid & 63, wr = wid >> 2, wc = wid & 3, fr = lane & 15, fq = lane >> 4;
    const int K = g.K, nt = K / BK;
    unsigned voffA[2], voffB[2];
#pragma unroll
    for (int i = 0; i < 2; ++i) { int R, C; stage_rc(tid * 16 + i * 8192, R, C); const int Rb = Epi::PERM ? ((R & ~31) + perm32(R & 31)) : R;
        voffA[i] = (unsigned)(R * g.lda + C) * 2u; voffB[i] = (unsigned)(Rb * g.ldb + C) * 2u; }
    const size_t kstep = (size_t)(BK * 2);
    const size_t hsA = (size_t)HALF * g.lda * 2, hsB = (size_t)HALF * g.ldb * 2;
    const size_t tsA = 2 * hsA, tsB = 2 * hsB;
    const unsigned ldsw = (unsigned)wid * 1024u;
    const int aoff = lds_byte(wr * 64 + fr, fq * 8), boff = lds_byte(wc * 32 + fr, fq * 8);
#define PG8_SA(b, h) (((b) * 2 + (h)) * HTB)
#define PG8_SB(b, h) ((4 + (b) * 2 + (h)) * HTB)
#define PG8_STAGE(bufoff, gbase, voff) do { _Pragma("unroll") for (int _i = 0; _i < 2; ++_i) \
        __builtin_amdgcn_global_load_lds((const unsigned*)((const char*)(gbase) + (voff)[_i]), (LAS unsigned*)(lds + (bufoff) + ldsw + _i * 8192), 16, 0, 0); } while (0)
#define PG8_LDA(dst, b, h) do { _Pragma("unroll") for (int m = 0; m < 4; ++m) _Pragma("unroll") for (int k = 0; k < 2; ++k) dst[m][k] = *(const LAS bf16x8*)(lds + PG8_SA(b, h) + aoff + m * 2048 + k * 1024); } while (0)
#define PG8_LDB(dst, b, h) do { _Pragma("unroll") for (int n = 0; n < 2; ++n) _Pragma("unroll") for (int k = 0; k < 2; ++k) dst[n][k] = *(const LAS bf16x8*)(lds + PG8_SB(b, h) + boff + n * 2048 + k * 1024); } while (0)
#define PG8_MMA(ai, bj, At, Bt) do { __builtin_amdgcn_s_setprio(1); _Pragma("unroll") for (int m = 0; m < 4; ++m) _Pragma("unroll") for (int n = 0; n < 2; ++n) _Pragma("unroll") for (int k = 0; k < 2; ++k) \
        acc[ai][bj][m][n] = __builtin_amdgcn_mfma_f32_16x16x32_bf16(Bt[n][k], At[m][k], acc[ai][bj][m][n], 0, 0, 0); __builtin_amdgcn_s_setprio(0); } while (0)
#define PG8_WAIT_V(n) asm volatile("s_waitcnt vmcnt(" #n ")" ::: "memory")
#define PG8_WAIT_L(n) asm volatile("s_waitcnt lgkmcnt(" #n ")" ::: "memory")
#define PG8_BAR __builtin_amdgcn_s_barrier()
#define PG8_SCHED __builtin_amdgcn_sched_barrier(0)
    Unit cur, nxt; int ui = 0;
    if (!S.next(0, cur)) return;
    f32x4 acc[2][2][4][2];
#pragma unroll
    for (int a = 0; a < 2; ++a)
#pragma unroll
        for (int b = 0; b < 2; ++b)
#pragma unroll
            for (int m = 0; m < 4; ++m)
#pragma unroll
                for (int n = 0; n < 2; ++n) acc[a][b][m][n] = (f32x4){0.f, 0.f, 0.f, 0.f};
    bf16x8 At[4][2], B0[2][2], B1[2][2];
    const char* cA = (const char*)g.A + (size_t)cur.pm * tsA + S.aoff(cur);
    const char* cB = (const char*)g.Bt + (size_t)cur.pn * tsB + (size_t)(cur.pm >> g.bshift) * g.bgs * 2 + S.boff(cur);
    PG8_STAGE(PG8_SB(0, 0), cB, voffB); PG8_STAGE(PG8_SB(0, 1), cB + hsB, voffB); PG8_STAGE(PG8_SA(0, 0), cA, voffA); PG8_STAGE(PG8_SA(0, 1), cA + hsA, voffA);
    if (wr == 1) PG8_BAR;
    PG8_WAIT_V(2); PG8_BAR;
    PG8_STAGE(PG8_SB(1, 0), cB + kstep, voffB); PG8_STAGE(PG8_SA(1, 0), cA + kstep, voffA); PG8_STAGE(PG8_SB(1, 1), cB + hsB + kstep, voffB);
    PG8_WAIT_V(6); PG8_BAR;
    for (;;) {
        const bool has_next = S.next(ui + 1, nxt);
        const char* nA = has_next ? (const char*)g.A + (size_t)nxt.pm * tsA + S.aoff(nxt) : cA;
        const char* nB = has_next ? (const char*)g.Bt + (size_t)nxt.pn * tsB + (size_t)(nxt.pm >> g.bshift) * g.bgs * 2 + S.boff(nxt) : cB;
        for (int t = 0; t < nt; t += 2) {
            const bool last = (t == nt - 2);
            const char* a1 = cA + (size_t)(t + 1) * kstep;
            const char* a2 = last ? nA : cA + (size_t)(t + 2) * kstep; const char* b2 = last ? nB : cB + (size_t)(t + 2) * kstep;
            const char* a3 = a2 + kstep; const char* b3 = b2 + kstep;
            PG8_LDB(B0, 0, 0); PG8_LDB(B1, 0, 1); PG8_SCHED; PG8_LDA(At, 0, 0); PG8_STAGE(PG8_SA(1, 1), a1 + hsA, voffA);
            PG8_WAIT_V(8); PG8_WAIT_L(0); PG8_BAR; PG8_MMA(0, 0, At, B0); PG8_MMA(0, 1, At, B1); PG8_BAR; PG8_SCHED;
            PG8_LDA(At, 0, 1); PG8_STAGE(PG8_SB(0, 0), b2, voffB); PG8_STAGE(PG8_SB(0, 1), b2 + hsB, voffB); PG8_STAGE(PG8_SA(0, 0), a2, voffA);
            PG8_WAIT_V(8); PG8_WAIT_L(0); PG8_BAR; PG8_MMA(1, 0, At, B0); PG8_MMA(1, 1, At, B1); PG8_BAR; PG8_SCHED;
            PG8_LDB(B0, 1, 0); PG8_LDB(B1, 1, 1); PG8_SCHED; PG8_LDA(At, 1, 0); PG8_STAGE(PG8_SA(0, 1), a2 + hsA, voffA);
            PG8_WAIT_V(8); PG8_WAIT_L(0); PG8_BAR; PG8_MMA(0, 0, At, B0); PG8_MMA(0, 1, At, B1); PG8_BAR; PG8_SCHED;
            PG8_LDA(At, 1, 1); PG8_STAGE(PG8_SB(1, 0), b3, voffB); PG8_STAGE(PG8_SB(1, 1), b3 + hsB, voffB); PG8_STAGE(PG8_SA(1, 0), a3, voffA);
            PG8_WAIT_V(8); PG8_WAIT_L(0); PG8_BAR; PG8_MMA(1, 0, At, B0); PG8_MMA(1, 1, At, B1); PG8_BAR; PG8_SCHED;
        }
        if constexpr (ALIGN_EPI) { if (wr == 0) PG8_BAR; }
        E(acc, cur, wr, wc, fr, fq);
        if (!has_next) break;
#pragma unroll
        for (int a = 0; a < 2; ++a)
#pragma unroll
            for (int b = 0; b < 2; ++b)
#pragma unroll
                for (int m = 0; m < 4; ++m)
#pragma unroll
                    for (int n = 0; n < 2; ++n) acc[a][b][m][n] = (f32x4){0.f, 0.f, 0.f, 0.f};
        cur = nxt; cA = nA; cB = nB; ++ui;
        if constexpr (ALIGN_EPI) { if (wr == 1) PG8_BAR; }
    }
    PG8_WAIT_V(0);
    if constexpr (!ALIGN_EPI) { if (wr == 0) PG8_BAR; }
    PG8_BAR;
#undef PG8_SA
#undef PG8_SB
#undef PG8_STAGE
#undef PG8_LDA
#undef PG8_LDB
#undef PG8_MMA
#undef PG8_WAIT_V
#undef PG8_WAIT_L
#undef PG8_BAR
#undef PG8_SCHED
}

typedef const f32x4 (&AccRef)[2][2][4][2];
enum { EM_FB16 = 0, EM_BF16 = 1, EM_SWIGLU = 2, EM_MIXIN = 3, EM_BR0 = 4, EM_BR1 = 5, EM_GLU = 6, EM_S5Y = 7, EM_F32Z = 8, EM_BR2 = 9, EM_BRANCH = 10 };
struct GEpi {
    static constexpr bool PERM = true;
    int mode_; int gcol_; unsigned char* ws; const float* dskip;
    __device__ __forceinline__ void operator()(AccRef acc, const Unit& u, int wr, int wc, int fr, int fq) const {
        const int mode = mode_ == EM_BRANCH ? (u.sel == 0 ? EM_BR0 : (u.sel == 1 ? EM_BR1 : (u.sel == 2 ? EM_BR2 : EM_GLU))) : mode_;
        const int gcol = mode_ == EM_BRANCH ? (u.sel == 0 ? 2048 : (u.sel == 1 ? 4096 : 5120)) : gcol_;
        float* of = (float*)(ws + WS_Z); const float* pf = dskip;
        bf16_t* ob = (bf16_t*)(ws + (mode == EM_BF16 ? WS_VT : (mode == EM_GLU || mode == EM_BR2 ? WS_H : (mode == EM_S5Y ? WS_ACAT : (mode == EM_FB16 || mode == EM_BR0 ? WS_F : (mode == EM_BR1 ? WS_F + (size_t)T_ * D_ * 2 : WS_P))))));
        bf16_t* ob2 = (bf16_t*)(ws + WS_ASSM); const bf16_t* pb = (const bf16_t*)(ws + (mode == EM_S5Y ? WS_ASSM : WS_P));
        const int ldc = mode == EM_F32Z ? 256 : (mode == EM_BF16 ? T_ : (mode == EM_SWIGLU ? FF_ : D_));
        const int row0 = u.pm * BM + wr * 64 + fr;
        if (mode == EM_F32Z) {
#pragma unroll
            for (int ai = 0; ai < 2; ++ai)
#pragma unroll
                for (int m = 0; m < 4; ++m) { float* rowp = of + (size_t)(row0 + ai * HALF + m * 16) * ldc + u.pn * BM + wc * 32 + 8 * fq;
#pragma unroll
                    for (int bj = 0; bj < 2; ++bj) { *(f32x4*)(rowp + bj * HALF) = acc[ai][bj][m][0]; *(f32x4*)(rowp + bj * HALF + 4) = acc[ai][bj][m][1]; } }
        } else if (mode == EM_BF16 || mode == EM_FB16) {
#pragma unroll
            for (int ai = 0; ai < 2; ++ai)
#pragma unroll
                for (int m = 0; m < 4; ++m) { bf16_t* rowp = ob + (size_t)(row0 + ai * HALF + m * 16) * ldc + u.pn * BM + wc * 32 + 8 * fq;
#pragma unroll
                    for (int bj = 0; bj < 2; ++bj) { const f32x4 v0 = acc[ai][bj][m][0], v1 = acc[ai][bj][m][1];
                        u32x4 w; w.x = cvt_pk_bf16(v0[0], v0[1]); w.y = cvt_pk_bf16(v0[2], v0[3]); w.z = cvt_pk_bf16(v1[0], v1[1]); w.w = cvt_pk_bf16(v1[2], v1[3]);
                        *(u32x4*)(rowp + bj * HALF) = w; } }
        } else if (mode == EM_SWIGLU) {
#pragma unroll
            for (int ai = 0; ai < 2; ++ai)
#pragma unroll
                for (int m = 0; m < 4; ++m) { bf16_t* rowp = ob + (size_t)(row0 + ai * HALF + m * 16) * ldc + u.pn * HALF + wc * 32 + 8 * fq;
                    float v[8];
#pragma unroll
                    for (int n = 0; n < 2; ++n)
#pragma unroll
                        for (int i = 0; i < 4; ++i) { const float a = acc[ai][0][m][n][i], b = acc[ai][1][m][n][i]; v[4 * n + i] = a * sigmoidf_(a) * b; }
                    *(u32x4*)rowp = pack8(v); }
        } else if (mode == EM_MIXIN) {
            const bool ssm = u.pn == 3;
#pragma unroll
            for (int ai = 0; ai < 2; ++ai)
#pragma unroll
                for (int m = 0; m < 4; ++m) { const int r = row0 + ai * HALF + m * 16;
#pragma unroll
                    for (int bj = 0; bj < 2; ++bj) { const int cl = bj * HALF + wc * 32 + 8 * fq;
                        float v[8];
#pragma unroll
                        for (int n = 0; n < 2; ++n)
#pragma unroll
                            for (int i = 0; i < 4; ++i) v[4 * n + i] = acc[ai][bj][m][n][i];
                        bf16_t* dst = ssm ? ob2 + ((size_t)((cl >> 4) * 1024 + (r >> 4))) * 384 + (r & 15) * 16 + (cl & 15)
                                          : ob + (size_t)r * NIN + u.pn * BM + cl;
                        *(u32x4*)dst = pack8(v); } }
        } else if (mode == EM_BR0 || mode == EM_BR1 || mode == EM_BR2) {
#pragma unroll
            for (int ai = 0; ai < 2; ++ai)
#pragma unroll
                for (int m = 0; m < 4; ++m) { const int r = row0 + ai * HALF + m * 16;
#pragma unroll
                    for (int bj = 0; bj < 2; ++bj) { const int col = u.pn * BM + bj * HALF + wc * 32 + 8 * fq;
                        float gt[8]; unpack8(*(const u32x4*)(pb + (size_t)r * NIN + gcol + col), gt);
                        float v[8];
#pragma unroll
                        for (int i = 0; i < 4; ++i) { v[i] = gt[i] * acc[ai][bj][m][0][i]; v[4 + i] = gt[4 + i] * acc[ai][bj][m][1][i]; }
                        *(u32x4*)(ob + (size_t)r * D_ + col) = pack8(v); } }
        } else if (mode == EM_GLU) {
            const int col = u.pn * HALF + wc * 32 + 8 * fq;
            const bf16_t* g0 = (const bf16_t*)(ws + WS_F); const bf16_t* g1 = g0 + (size_t)T_ * D_;
#pragma unroll
            for (int ai = 0; ai < 2; ++ai)
#pragma unroll
                for (int m = 0; m < 4; ++m) { const int r = row0 + ai * HALF + m * 16;
                    float gt[8], p0[8], p1[8], p2[8];
                    unpack8(*(const u32x4*)(pb + (size_t)r * NIN + 2048 + 1024 + col), gt);
                    unpack8(*(const u32x4*)(g0 + (size_t)r * D_ + col), p0); unpack8(*(const u32x4*)(g1 + (size_t)r * D_ + col), p1); unpack8(*(const u32x4*)(ob + (size_t)r * D_ + col), p2);
                    float v[8];
#pragma unroll
                    for (int n = 0; n < 2; ++n)
#pragma unroll
                        for (int i = 0; i < 4; ++i) { const float a = acc[ai][0][m][n][i], g = acc[ai][1][m][n][i];
                            v[4 * n + i] = (p0[4 * n + i] + p1[4 * n + i]) + (p2[4 * n + i] + gt[4 * n + i] * a * sigmoidf_(g)); }
                    *(u32x4*)(ob + (size_t)r * D_ + col) = pack8(v); }
        } else {
#pragma unroll
            for (int ai = 0; ai < 2; ++ai)
#pragma unroll
                for (int m = 0; m < 4; ++m) { const int r = row0 + ai * HALF + m * 16, g = r >> 10, chunk = r & 1023;
#pragma unroll
                    for (int bj = 0; bj < 2; ++bj) { const int cl = bj * HALF + wc * 32 + 8 * fq, ii = cl >> 4, h0 = cl & 15;
                        float uu[8]; unpack8(*(const u32x4*)(pb + (size_t)r * 384 + cl), uu);
                        const f32x4 d0 = *(const f32x4*)(pf + g * 16 + h0), d1 = *(const f32x4*)(pf + g * 16 + h0 + 4);
                        float v[8];
#pragma unroll
                        for (int n = 0; n < 2; ++n)
#pragma unroll
                            for (int i = 0; i < 4; ++i) { const float y = acc[ai][bj][m][n][i] + (n == 0 ? d0[i] : d1[i]) * uu[4 * n + i];
                                v[4 * n + i] = y * sigmoidf_(1.5957691216f * (y + 0.044715f * y * y * y)); }
                        *(u32x4*)(ob + (size_t)(chunk * 16 + ii) * D_ + 256 + g * 16 + h0) = pack8(v); } }
        }
    }
};
}

#define XB_TMO      128
#define XB_XCNT(j)  (256  + 64 * (j))
#define XB_XSUB(j)  (1280 + 64 * (j))
#define XB_XGEN(j)  (2304 + 64 * (j))
#define XB_TOP      3328
#define XB_TOPGEN   3392
#define XCD_BAR_WORDS 3456
#define XB_SPIN_CAP (1u << 18)

__device__ __forceinline__ unsigned xb_ld(unsigned* p)              { return __hip_atomic_load(p, __ATOMIC_RELAXED, __HIP_MEMORY_SCOPE_AGENT); }
__device__ __forceinline__ unsigned xb_add(unsigned* p, unsigned v) { return __hip_atomic_fetch_add(p, v, __ATOMIC_RELAXED, __HIP_MEMORY_SCOPE_AGENT); }
__device__ __forceinline__ unsigned xb_xcc_id() { return (unsigned)__builtin_amdgcn_s_getreg((3 << 11) | 20) & 0xFu; }
#define XB_SPIN(cond, bar) do { unsigned _sp = 0; while (cond) { __builtin_amdgcn_s_sleep(1); \
    if ((++_sp & 255u) == 0u) { if (xb_ld(&(bar)[XB_TMO])) break; if (_sp > XB_SPIN_CAP) { atomicAdd(&(bar)[XB_TMO], 1u); break; } } } } while (0)

struct XcdBarrier {
    unsigned* bar; unsigned x;
    volatile LAS unsigned* st;
};

__device__ __forceinline__ XcdBarrier xcd_barrier_post(unsigned* bar, volatile LAS unsigned* st) {
    XcdBarrier b; b.bar = bar; b.x = xb_xcc_id(); b.st = st;
    if (threadIdx.x == 0) (void)xb_add(&bar[XB_XCNT(b.x)], 1u);
    return b;
}
__device__ __forceinline__ void xcd_barrier_complete(unsigned* bar, unsigned x, unsigned& nloc, unsigned& nx) {
    const unsigned G = gridDim.x * gridDim.y * gridDim.z;
    unsigned sum, cnt, mine, sp = 0u;
    for (;;) {
        sum = 0u; cnt = 0u; mine = 0u;
#pragma unroll
        for (unsigned j = 0; j < 16; ++j) { const unsigned c = xb_ld(&bar[XB_XCNT(j)]); sum += c; cnt += (c > 0u) ? 1u : 0u; mine = (j == x) ? c : mine; }
        if (sum == G) break;
        __builtin_amdgcn_s_sleep(1);
        if ((++sp & 255u) == 0u) { if (xb_ld(&bar[XB_TMO])) break; if (sp > XB_SPIN_CAP) { atomicAdd(&bar[XB_TMO], 1u); break; } }
    }
    nloc = mine > 0u ? mine : 1u; nx = cnt > 0u ? cnt : 1u;
}

__device__ __forceinline__ void xcd_barrier(const XcdBarrier& b) {
    asm volatile("s_waitcnt vmcnt(0)" ::: "memory");
    __syncthreads();
    if (threadIdx.x == 0) {
        unsigned* bar = b.bar;
        __builtin_amdgcn_s_waitcnt(0);
        unsigned nloc = b.st[0], nx = b.st[1];
        if (nloc == 0u) { xcd_barrier_complete(bar, b.x, nloc, nx); b.st[0] = nloc; b.st[1] = nx; }
        const unsigned old = xb_add(&bar[XB_XSUB(b.x)], 1u);
        const unsigned gen = old / nloc;
        if (old + 1u == (gen + 1u) * nloc) {
            __builtin_amdgcn_fence(__ATOMIC_RELEASE, "agent");
            asm volatile("s_waitcnt vmcnt(0)" ::: "memory");
            const unsigned og = xb_add(&bar[XB_TOP], 1u);
            const unsigned tg = og / nx;
            if (og + 1u == (tg + 1u) * nx) xb_add(&bar[XB_TOPGEN], 1u);
            else XB_SPIN(xb_ld(&bar[XB_TOPGEN]) == tg, bar);
            __builtin_amdgcn_fence(__ATOMIC_ACQUIRE, "agent");
            xb_add(&bar[XB_XGEN(b.x)], 1u);
            asm volatile("s_waitcnt vmcnt(0)" ::: "memory");
        } else {
            XB_SPIN(xb_ld(&bar[XB_XGEN(b.x)]) == gen, bar);
            __builtin_amdgcn_fence(__ATOMIC_ACQUIRE, "agent");
            asm volatile("s_waitcnt vmcnt(0)" ::: "memory");
        }
    }
    __syncthreads();
}

struct Args { const float* in[25]; float* out; unsigned char* ws; int ph_lo, ph_hi, coop, pad; };
struct Ctx {
    LAS const unsigned long long* tab; unsigned char* ws;
    __device__ __forceinline__ const float* in(int i) const { const unsigned long long v = tab[i];
        const unsigned lo = __builtin_amdgcn_readfirstlane((unsigned)v), hi = __builtin_amdgcn_readfirstlane((unsigned)(v >> 32));
        return (const float*)(GAS const float*)(((unsigned long long)hi << 32) | lo); }
};

struct TItem { const float* src; bf16_t* dst; int N, K, dst_row0, k0, n0; float scale; };
constexpr int IT_FFIN = (D_ / 64) * (2 * FF_ / 32), IT_FFOUT = (FF_ / 64) * (D_ / 32), IT_WIN = (D_ / 64) * (NIN / 32);
constexpr int IT_BR = (256 / 64) * (D_ / 32), IT_GLU = (256 / 64) * (2048 / 32), IT_WOUT = (D_ / 64) * (D_ / 32), IT_POOL = 4 * 16;
constexpr int IT_TILES = 2 * IT_FFIN + 2 * IT_FFOUT + IT_WIN + 2 * IT_BR + IT_GLU + IT_WOUT;

__device__ __forceinline__ void t_decode(const Ctx& a, int it, TItem& t) {
    const int l = it / IT_TILES; int r = it % IT_TILES;
    unsigned char* wl = a.ws + WS_W + (size_t)l * LAYER_W;
    t.scale = 1.f;
    if (r < 2 * IT_FFIN) { const int s = r / IT_FFIN; r %= IT_FFIN; const int nblk = 2 * FF_ / 32, kb = r / nblk, nb = r % nblk, n0 = 32 * nb;
        const int half = n0 >= FF_, j = n0 - half * FF_;
        t.src = a.in(6) + (size_t)(l * 2 + s) * D_ * 2 * FF_; t.N = 2 * FF_; t.K = D_; t.dst = (bf16_t*)(wl + OFF_FFIN0 + s * SZ_FFIN); t.dst_row0 = 256 * (j >> 7) + 128 * half + (j & 127); t.k0 = 64 * kb; t.n0 = n0; return; }
    r -= 2 * IT_FFIN;
    if (r < 2 * IT_FFOUT) { const int s = r / IT_FFOUT; r %= IT_FFOUT; const int nblk = D_ / 32, kb = r / nblk, nb = r % nblk;
        t.src = a.in(7) + (size_t)(l * 2 + s) * FF_ * D_; t.N = D_; t.K = FF_; t.dst = (bf16_t*)(wl + OFF_FFOUT0 + s * SZ_FFOUT); t.dst_row0 = 32 * nb; t.k0 = 64 * kb; t.n0 = 32 * nb; return; }
    r -= 2 * IT_FFOUT;
    if (r < IT_WIN) { const int nblk = NIN / 32, kb = r / nblk, nb = r % nblk, n0 = 32 * nb;
        t.scale = (n0 >= 1280 && n0 < 1536) ? 0.125f : 1.f;
        t.src = a.in(8) + (size_t)l * D_ * NIN; t.N = NIN; t.K = D_; t.dst = (bf16_t*)(wl + OFF_WIN); t.dst_row0 = n0; t.k0 = 64 * kb; t.n0 = n0; return; }
    r -= IT_WIN;
    if (r < 2 * IT_BR) { const int s = r / IT_BR; r %= IT_BR; const int nblk = D_ / 32, kb = r / nblk, nb = r % nblk;
        t.src = a.in(s == 0 ? 10 : 23) + (size_t)l * 256 * D_; t.N = D_; t.K = 256; t.dst = (bf16_t*)(wl + (s == 0 ? OFF_WCONV : OFF_WSB)); t.dst_row0 = 32 * nb; t.k0 = 64 * kb; t.n0 = 32 * nb; return; }
    r -= 2 * IT_BR;
    if (r < IT_GLU) { const int nblk = 2048 / 32, kb = r / nblk, nb = r % nblk, n0 = 32 * nb; const int half = n0 >= 1024, j = n0 - half * 1024;
        t.src = a.in(19) + (size_t)l * 256 * 2048; t.N = 2048; t.K = 256; t.dst = (bf16_t*)(wl + OFF_WGLU); t.dst_row0 = 256 * (j >> 7) + 128 * half + (j & 127); t.k0 = 64 * kb; t.n0 = n0; return; }
    r -= IT_GLU;
    { const int nblk = D_ / 32, kb = r / nblk, nb = r % nblk;
        t.src = a.in(24) + (size_t)l * D_ * D_; t.N = D_; t.K = D_; t.dst = (bf16_t*)(wl + OFF_WOUT); t.dst_row0 = 32 * nb; t.k0 = 64 * kb; t.n0 = 32 * nb; }
}
__device__ __forceinline__ void t_load(const TItem& t, f32x4 (&r)[8], int lane) {
    const float* p = t.src + (size_t)(t.k0 + (lane >> 3)) * t.N + t.n0 + 4 * (lane & 7);
#pragma unroll
    for (int i = 0; i < 8; ++i) r[i] = __builtin_nontemporal_load((const f32x4*)(p + (size_t)(8 * i) * t.N));
}
__device__ __forceinline__ void t_finish(const TItem& t, const f32x4 (&r)[8], LAS float* scr, int lane) {
    LAS float* w = scr + (lane >> 3) * 33 + 4 * (lane & 7);
#pragma unroll
    for (int i = 0; i < 8; ++i) { w[(8 * i) * 33 + 0] = r[i].x * t.scale; w[(8 * i) * 33 + 1] = r[i].y * t.scale; w[(8 * i) * 33 + 2] = r[i].z * t.scale; w[(8 * i) * 33 + 3] = r[i].w * t.scale; }
    asm volatile("s_waitcnt lgkmcnt(0)" ::: "memory");
    const int c = lane & 7;
#pragma unroll
    for (int j = 0; j < 4; ++j) { const int n = (lane >> 3) + 8 * j; const LAS float* s = scr + (8 * c) * 33 + n;
        u32x4 o; o.x = cvt_pk_bf16(s[0 * 33], s[1 * 33]); o.y = cvt_pk_bf16(s[2 * 33], s[3 * 33]); o.z = cvt_pk_bf16(s[4 * 33], s[5 * 33]); o.w = cvt_pk_bf16(s[6 * 33], s[7 * 33]);
        *(u32x4*)(t.dst + (size_t)(t.dst_row0 + n) * t.K + t.k0 + 8 * c) = o; }
    asm volatile("s_waitcnt lgkmcnt(0)" ::: "memory");
}
__device__ __forceinline__ void p0_transposes(const Ctx& a, int gw, int ngw, LAS float* scr, int lane) {
    constexpr int NT = DEPTH * IT_TILES;
    int it = gw; TItem ta, tb; f32x4 ra[8], rb[8];
    if (it < NT) { t_decode(a, it, ta); t_load(ta, ra, lane); }
    while (it < NT) {
        const int nx = it + ngw; const bool hn = nx < NT;
        if (hn) { t_decode(a, nx, tb); t_load(tb, rb, lane); }
        t_finish(ta, ra, scr, lane);
        if (hn) { ta = tb;
#pragma unroll
            for (int i = 0; i < 8; ++i) ra[i] = rb[i]; }
        it = nx;
    }
}
__device__ __forceinline__ void p0_pool_item(const Ctx& a, int it, int lane) {
    const int l = it >> 6, r = it & 63;
    unsigned char* wl = a.ws + WS_W + (size_t)l * LAYER_W;
    const int gi = r >> 4, n = (r & 15) * 64 + lane;
    const float* wp = a.in(20) + (size_t)l * 4 * 64 * 64 + (size_t)gi * 64 * 64;
    const float* ps = a.in(21) + (size_t)l * 256 + gi * 64;
    const float* wo = a.in(22) + (size_t)l * 256 * D_ + (size_t)gi * 64 * D_ + n;
    bf16_t* dst = (bf16_t*)(wl + OFF_WPOOL) + (size_t)n * 256 + gi * 64;
    float wv[64];
#pragma unroll
    for (int d = 0; d < 64; ++d) wv[d] = wo[(size_t)d * D_] * ps[d];
    for (int c8 = 0; c8 < 8; ++c8) { float v[8];
#pragma unroll
        for (int cc = 0; cc < 8; ++cc) { const float* wr_ = wp + (c8 * 8 + cc) * 64; float s = 0.f;
#pragma unroll
            for (int d = 0; d < 64; ++d) s += wr_[d] * wv[d];
            v[cc] = s; }
        *(u32x4*)(dst + c8 * 8) = pack8(v); }
}

__device__ __forceinline__ void p0_ada(const Ctx& a, LAS float* lds, int tid, int lane, int wave, int bid, int G) {
    LAS float* cact = lds;
    LAS float* red = lds + 8192;
    for (int i = tid; i < NB * D_; i += 512) { const float c = a.in(1)[i]; cact[i] = c * sigmoidf_(c); }
    __syncthreads();
    float* ADA = (float*)(a.ws + WS_ADA);
    for (int it = bid; it < DEPTH * 36; it += G) {
        const int l = it / 36, col0 = (it % 36) * 256;
        const int kb = wave * 128;
        const float* w = a.in(2) + (size_t)l * D_ * 9216 + (size_t)kb * 9216 + col0 + 4 * lane;
        f32x4 acc[8];
#pragma unroll
        for (int b = 0; b < 8; ++b) acc[b] = (f32x4){0.f, 0.f, 0.f, 0.f};
#pragma unroll 2
        for (int k4 = 0; k4 < 32; ++k4) {
            f32x4 wv[4];
#pragma unroll
            for (int j = 0; j < 4; ++j) wv[j] = __builtin_nontemporal_load((const f32x4*)(w + (size_t)(4 * k4 + j) * 9216));
#pragma unroll
            for (int b = 0; b < 8; ++b) { const f32x4 c = *(const LAS f32x4*)(cact + b * 1024 + kb + 4 * k4);
                acc[b] += c.x * wv[0] + c.y * wv[1] + c.z * wv[2] + c.w * wv[3]; }
        }
#pragma unroll
        for (int b = 0; b < 8; ++b) *(LAS f32x4*)(red + (wave * 8 + b) * 256 + 4 * lane) = acc[b];
        __syncthreads();
        { const int b = tid >> 6, c4 = (tid & 63) * 4; f32x4 s = *(const f32x4*)(a.in(3) + (size_t)l * 9216 + col0 + c4);
#pragma unroll
          for (int w2 = 0; w2 < 8; ++w2) s += *(const LAS f32x4*)(red + (w2 * 8 + b) * 256 + c4);
          *(f32x4*)(ADA + ((size_t)l * 8 + b) * 9216 + col0 + c4) = s; }
        __syncthreads();
    }
}

__device__ __forceinline__ void p0_tables(const Ctx& a, int gt, int ngt) {
    float* APOW = (float*)(a.ws + WS_APOW); float* BB = (float*)(a.ws + WS_BB);
    for (int i = gt; i < DEPTH * 16 * 64; i += ngt) {
        const int l = i >> 10, g = (i >> 6) & 15;
        const float lr = fminf(a.in(11)[i], -1e-4f), li = a.in(12)[i], dt = __expf(a.in(13)[l * 16 + g]);
        float abr = 1.f, abi = 0.f;
        for (int tau = 0; tau <= 16; ++tau) {
            const float mg = __expf((float)tau * lr * dt);
            float rev = (float)tau * li * dt * 0.15915494309189535f; rev -= floorf(rev);
            const float cr = mg * __builtin_amdgcn_cosf(rev), ci = mg * __builtin_amdgcn_sinf(rev);
            APOW[((size_t)i * 17 + tau) * 2] = cr; APOW[((size_t)i * 17 + tau) * 2 + 1] = ci;
            if (tau == 1) { abr = cr; abi = ci; }
        }
        const float den = lr * lr + li * li, nr = abr - 1.0f;
        const float fre = (nr * lr + abi * li) / den, fim = (abi * lr - nr * li) / den;
        for (int h = 0; h < 16; ++h) { const float br = a.in(14)[(size_t)i * 16 + h], bi = a.in(15)[(size_t)i * 16 + h];
            BB[((size_t)i * 16 + h) * 2] = fre * br - fim * bi; BB[((size_t)i * 16 + h) * 2 + 1] = fre * bi + fim * br; }
    }
}
__device__ __forceinline__ void p1_kern(const Ctx& a, int gt, int ngt) {
    const float* APOW = (const float*)(a.ws + WS_APOW); const float* BB = (const float*)(a.ws + WS_BB); float* KERN = (float*)(a.ws + WS_KERN);
    for (int i = gt; i < DEPTH * 16 * 16 * 256; i += ngt) {
        const int hp = i & 15, h = (i >> 4) & 15, tau = (i >> 8) & 15, lg = i >> 12;
        const float* cre = a.in(16) + ((size_t)lg * 16 + h) * 64; const float* cim = a.in(17) + ((size_t)lg * 16 + h) * 64;
        float s = 0.f;
        for (int p = 0; p < 64; ++p) {
            const float ar = APOW[(((size_t)lg * 64 + p) * 17 + tau) * 2], ai = APOW[(((size_t)lg * 64 + p) * 17 + tau) * 2 + 1];
            const float br = BB[(((size_t)lg * 64 + p) * 16 + hp) * 2], bi = BB[(((size_t)lg * 64 + p) * 16 + hp) * 2 + 1];
            const float cr = cre[p], ci = cim[p];
            const float car = cr * ar - ci * ai, cai = cr * ai + ci * ar;
            s += car * br - cai * bi;
        }
        KERN[i] = s;
    }
}
__device__ __forceinline__ void p2_fill(const Ctx& a, int gt, int ngt) {
    const float* APOW = (const float*)(a.ws + WS_APOW); const float* BB = (const float*)(a.ws + WS_BB); const float* KERN = (const float*)(a.ws + WS_KERN);
    constexpr int TMC = 16 * 256 * 48, WZC = 16 * 256 * 32;
    for (int it = gt; it < DEPTH * (TMC + WZC); it += ngt) {
        const int l = it / (TMC + WZC); int r = it % (TMC + WZC);
        unsigned char* wl = a.ws + WS_W + (size_t)l * LAYER_W;
        float v[8];
        if (r < TMC) {
            const int kc = r % 48, n = (r / 48) & 255, g = r / (48 * 256), i = n >> 4, h = n & 15, lg = l * 16 + g;
            if (kc < 32) { const int j = kc >> 1, hp0 = (kc & 1) * 8;
#pragma unroll
                for (int q = 0; q < 8; ++q) v[q] = (j <= i) ? KERN[(((size_t)lg * 16 + (i - j)) * 16 + h) * 16 + hp0 + q] : 0.f;
            } else { const int p0 = (kc - 32) * 4;
#pragma unroll
                for (int q = 0; q < 4; ++q) { const int p = p0 + q;
                    const float ar = APOW[(((size_t)lg * 64 + p) * 17 + i + 1) * 2], ai = APOW[(((size_t)lg * 64 + p) * 17 + i + 1) * 2 + 1];
                    const float cr = a.in(16)[((size_t)lg * 16 + h) * 64 + p], ci = a.in(17)[((size_t)lg * 16 + h) * 64 + p];
                    v[2 * q] = cr * ar - ci * ai; v[2 * q + 1] = -(cr * ai + ci * ar); } }
            *(u32x4*)((bf16_t*)(wl + OFF_TM) + ((size_t)g * 256 + n) * 384 + kc * 8) = pack8(v);
        } else {
            r -= TMC;
            const int kc = r & 31, n = (r >> 5) & 255, g = r >> 13, lg = l * 16 + g;
            if (n < 128) { const int p = n >> 1, part = n & 1, j = kc >> 1, hp0 = (kc & 1) * 8;
                const float ar = APOW[(((size_t)lg * 64 + p) * 17 + 15 - j) * 2], ai = APOW[(((size_t)lg * 64 + p) * 17 + 15 - j) * 2 + 1];
#pragma unroll
                for (int q = 0; q < 8; ++q) { const float br = BB[(((size_t)lg * 64 + p) * 16 + hp0 + q) * 2], bi = BB[(((size_t)lg * 64 + p) * 16 + hp0 + q) * 2 + 1];
                    v[q] = part ? (ar * bi + ai * br) : (ar * br - ai * bi); }
            } else {
#pragma unroll
                for (int q = 0; q < 8; ++q) v[q] = 0.f; }
            *(u32x4*)((bf16_t*)(wl + OFF_WZ) + ((size_t)g * 256 + n) * 256 + kc * 8) = pack8(v);
        }
    }
}

__device__ __forceinline__ void rowop(const float* xin32, const bf16_t* xinb, float* xout32, bf16_t* xoutb, const bf16_t* f, float resw, const float* ada_gate  , const float* gpost,
                                      bool do_h, const float* ada_mod  , const float* gpre, bf16_t* H, int gw, int ngw, int lane) {
    constexpr int NR = 4;
    for (int row0 = gw; row0 < T_; row0 += NR * ngw) {
        f32x4 xv[NR][4]; f32x4 fv[NR][4]; float ss[NR];
#pragma unroll
        for (int q = 0; q < NR; ++q) { const int row = (row0 + q * ngw) < T_ ? row0 + q * ngw : row0; const size_t ro = (size_t)row * D_ + 4 * lane;
#pragma unroll
            for (int j = 0; j < 4; ++j) { if (xin32) xv[q][j] = *(const f32x4*)(xin32 + ro + 256 * j);
                else { const u32x2 xw = *(const u32x2*)(xinb + ro + 256 * j); xv[q][j] = (f32x4){bf_lo(xw.x), bf_hi(xw.x), bf_lo(xw.y), bf_hi(xw.y)}; } }
            ss[q] = 0.f;
            if (f) {
#pragma unroll
                for (int j = 0; j < 4; ++j) { const u32x2 fw = *(const u32x2*)(f + ro + 256 * j); fv[q][j] = (f32x4){bf_lo(fw.x), bf_hi(fw.x), bf_lo(fw.y), bf_hi(fw.y)};
                    ss[q] += (fv[q][j].x * fv[q][j].x + fv[q][j].y * fv[q][j].y) + (fv[q][j].z * fv[q][j].z + fv[q][j].w * fv[q][j].w); } } }
#pragma unroll
        for (int q = 0; q < NR; ++q) { if ((row0 + q * ngw) >= T_) break;
            const int row = row0 + q * ngw, b = row >> 11; const size_t ro = (size_t)row * D_ + 4 * lane;
            if (f) {
                const float rs = rsqrtf(wave_sum(ss[q], lane) * (1.f / D_) + EPS_);
#pragma unroll
                for (int j = 0; j < 4; ++j) { const f32x4 gp = *(const f32x4*)(gpost + 4 * lane + 256 * j), gt = *(const f32x4*)(ada_gate + (size_t)b * 9216 + 4 * lane + 256 * j);
                    xv[q][j] = xv[q][j] + (resw * (gt + 1.0f)) * (fv[q][j] * rs * gp); }
            }
#pragma unroll
            for (int j = 0; j < 4; ++j) { if (xout32) *(f32x4*)(xout32 + ro + 256 * j) = xv[q][j];
                else { u32x2 w; w.x = cvt_pk_bf16(xv[q][j].x, xv[q][j].y); w.y = cvt_pk_bf16(xv[q][j].z, xv[q][j].w); *(u32x2*)(xoutb + ro + 256 * j) = w; } }
            if (do_h) {
                float s2 = 0.f;
#pragma unroll
                for (int j = 0; j < 4; ++j) s2 += (xv[q][j].x * xv[q][j].x + xv[q][j].y * xv[q][j].y) + (xv[q][j].z * xv[q][j].z + xv[q][j].w * xv[q][j].w);
                const float rs = rsqrtf(wave_sum(s2, lane) * (1.f / D_) + EPS_);
#pragma unroll
                for (int j = 0; j < 4; ++j) { const f32x4 gp = *(const f32x4*)(gpre + 4 * lane + 256 * j);
                    const f32x4 sh = *(const f32x4*)(ada_mod + (size_t)b * 9216 + 4 * lane + 256 * j), sc = *(const f32x4*)(ada_mod + (size_t)b * 9216 + 1024 + 4 * lane + 256 * j);
                    const f32x4 hv = (xv[q][j] * rs * gp) * (sc + 1.0f) + sh;
                    u32x2 w; w.x = cvt_pk_bf16(hv.x, hv.y); w.y = cvt_pk_bf16(hv.z, hv.w);
                    *(u32x2*)(H + ro + 256 * j) = w; }
            }
        }
    }
}

__device__ __forceinline__ void rowop_c(const float* xin32, const bf16_t* xinb, float* xout32, bf16_t* xoutb, const bf16_t* f, float resw, const float* ada_gate, const float* gpost,
                                        bool do_h, const float* ada_mod, const float* gpre, bf16_t* H, int gw, int lane) {
    constexpr int RPW = 8;
    const int rbeg = gw * RPW, b = rbeg >> 11;
    f32x4 cg[4], gpr[4], sh[4];
#pragma unroll
    for (int j = 0; j < 4; ++j) { cg[j] = (f32x4){0.f, 0.f, 0.f, 0.f}; gpr[j] = cg[j]; sh[j] = cg[j];
        if (f) { const f32x4 gpo = *(const f32x4*)(gpost + 4 * lane + 256 * j), gt = *(const f32x4*)(ada_gate + (size_t)b * 9216 + 4 * lane + 256 * j); cg[j] = (resw * (gt + 1.0f)) * gpo; }
        if (do_h) { const f32x4 gp = *(const f32x4*)(gpre + 4 * lane + 256 * j), sc = *(const f32x4*)(ada_mod + (size_t)b * 9216 + 1024 + 4 * lane + 256 * j);
            gpr[j] = gp * (sc + 1.0f); sh[j] = *(const f32x4*)(ada_mod + (size_t)b * 9216 + 4 * lane + 256 * j); } }
    u32x2 xr[RPW][4], fr[RPW][4]; f32x4 x32[RPW][4];
#pragma unroll
    for (int q = 0; q < RPW; ++q) { const size_t ro = (size_t)(rbeg + q) * D_ + 4 * lane;
#pragma unroll
        for (int j = 0; j < 4; ++j) {
            if (xin32) x32[q][j] = *(const f32x4*)(xin32 + ro + 256 * j); else xr[q][j] = *(const u32x2*)(xinb + ro + 256 * j);
            if (f) fr[q][j] = *(const u32x2*)(f + ro + 256 * j); } }
#pragma unroll
    for (int q = 0; q < RPW; ++q) { const size_t ro = (size_t)(rbeg + q) * D_ + 4 * lane;
        f32x4 xv[4]; float s2 = 0.f;
#pragma unroll
        for (int j = 0; j < 4; ++j) xv[j] = xin32 ? x32[q][j] : (f32x4){bf_lo(xr[q][j].x), bf_hi(xr[q][j].x), bf_lo(xr[q][j].y), bf_hi(xr[q][j].y)};
        if (f) { f32x4 fv[4]; float ss = 0.f;
#pragma unroll
            for (int j = 0; j < 4; ++j) { fv[j] = (f32x4){bf_lo(fr[q][j].x), bf_hi(fr[q][j].x), bf_lo(fr[q][j].y), bf_hi(fr[q][j].y)};
                ss += (fv[j].x * fv[j].x + fv[j].y * fv[j].y) + (fv[j].z * fv[j].z + fv[j].w * fv[j].w); }
            const float rs = rsqrtf(wave_sum(ss, lane) * (1.f / D_) + EPS_);
#pragma unroll
            for (int j = 0; j < 4; ++j) xv[j] = xv[j] + cg[j] * (fv[j] * rs); }
#pragma unroll
        for (int j = 0; j < 4; ++j) { s2 += (xv[j].x * xv[j].x + xv[j].y * xv[j].y) + (xv[j].z * xv[j].z + xv[j].w * xv[j].w);
            if (xout32) *(f32x4*)(xout32 + ro + 256 * j) = xv[j];
            else { u32x2 w; w.x = cvt_pk_bf16(xv[j].x, xv[j].y); w.y = cvt_pk_bf16(xv[j].z, xv[j].w); *(u32x2*)(xoutb + ro + 256 * j) = w; } }
        if (do_h) {
            const float r2 = rsqrtf(wave_sum(s2, lane) * (1.f / D_) + EPS_);
#pragma unroll
            for (int j = 0; j < 4; ++j) { const f32x4 hv = (xv[j] * r2) * gpr[j] + sh[j];
                u32x2 w; w.x = cvt_pk_bf16(hv.x, hv.y); w.y = cvt_pk_bf16(hv.z, hv.w);
                *(u32x2*)(H + ro + 256 * j) = w; }
        }
    }
}

template <int W> __device__ __forceinline__ void pool_block8(const bf16_t* P, bf16_t* ACAT, int t0, int c8) {
    const int tt0 = t0 & (L_ - 1);
    u32x4 raw[W + 7];
#pragma unroll
    for (int i = 0; i < W + 7; ++i) { raw[i] = (u32x4){0u, 0u, 0u, 0u}; if (tt0 + i - (W - 1) >= 0) raw[i] = *(const u32x4*)(P + (size_t)(t0 + i - (W - 1)) * NIN + 1024 + c8); }
    float s[8];
#pragma unroll
    for (int q = 0; q < 8; ++q) s[q] = 0.f;
#pragma unroll
    for (int i = 0; i < W - 1; ++i) { float uu[8]; unpack8(raw[i], uu);
#pragma unroll
        for (int q = 0; q < 8; ++q) s[q] += uu[q]; }
#pragma unroll
    for (int j = 0; j < 8; ++j) {
        float cur[8]; unpack8(raw[W - 1 + j], cur);
#pragma unroll
        for (int q = 0; q < 8; ++q) s[q] += cur[q];
        const int cnt = (tt0 + j + 1) < W ? (tt0 + j + 1) : W; const float inv = 1.0f / (float)cnt;
        float o[8];
#pragma unroll
        for (int q = 0; q < 8; ++q) o[q] = s[q] * inv - cur[q];
        *(u32x4*)(ACAT + (size_t)(t0 + j) * D_ + 512 + c8) = pack8(o);
        float old[8]; unpack8(raw[j], old);
#pragma unroll
        for (int q = 0; q < 8; ++q) s[q] -= old[q];
    }
}
__device__ __forceinline__ void conv_block8(const bf16_t* P, bf16_t* ACAT, const float* convw, int t0, int c8) {
    const int tt0 = t0 & (L_ - 1);
    u32x4 rc[10], rv[10], rb[8];
#pragma unroll
    for (int i = 0; i < 10; ++i) { rc[i] = (u32x4){0u, 0u, 0u, 0u}; rv[i] = rc[i]; if (tt0 + i - 2 >= 0) { const size_t ro = (size_t)(t0 + i - 2) * NIN; rc[i] = *(const u32x4*)(P + ro + 256 + c8); rv[i] = *(const u32x4*)(P + ro + 512 + c8); } }
#pragma unroll
    for (int j = 0; j < 8; ++j) rb[j] = *(const u32x4*)(P + (size_t)(t0 + j) * NIN + c8);
    float w[3][8];
#pragma unroll
    for (int k = 0; k < 3; ++k) { const f32x4 w0 = *(const f32x4*)(convw + k * 256 + c8), w1 = *(const f32x4*)(convw + k * 256 + c8 + 4);
#pragma unroll
        for (int q = 0; q < 4; ++q) { w[k][q] = w0[q]; w[k][4 + q] = w1[q]; } }
    float u0[8], u1[8], u2[8];
    { float a[8], b[8]; unpack8(rc[0], a); unpack8(rv[0], b);
#pragma unroll
      for (int q = 0; q < 8; ++q) u0[q] = a[q] * b[q];
      unpack8(rc[1], a); unpack8(rv[1], b);
#pragma unroll
      for (int q = 0; q < 8; ++q) u1[q] = a[q] * b[q]; }
#pragma unroll
    for (int j = 0; j < 8; ++j) {
        float a[8], b[8], g[8], o[8]; unpack8(rc[j + 2], a); unpack8(rv[j + 2], b); unpack8(rb[j], g);
#pragma unroll
        for (int q = 0; q < 8; ++q) { u2[q] = a[q] * b[q]; o[q] = g[q] * ((w[0][q] * u0[q] + w[1][q] * u1[q]) + w[2][q] * u2[q]); u0[q] = u1[q]; u1[q] = u2[q]; }
        *(u32x4*)(ACAT + (size_t)(t0 + j) * D_ + c8) = pack8(o);
    }
}
__device__ __forceinline__ void convpool(const bf16_t* P, bf16_t* ACAT, const float* convw  , int gt, int ngt) {
    constexpr int NI = T_ * 32 / 8;
    for (int it = gt; it < 2 * NI; it += ngt) {
        if (it < NI) { conv_block8(P, ACAT, convw, (it >> 5) * 8, (it & 31) * 8); }
        else { const int p = it - NI, gi = p >> 14, rem = p & 16383, t0 = (rem >> 3) * 8, c8 = gi * 64 + (rem & 7) * 8;
            if (gi == 0) pool_block8<2>(P, ACAT, t0, c8); else if (gi == 1) pool_block8<4>(P, ACAT, t0, c8); else if (gi == 2) pool_block8<8>(P, ACAT, t0, c8); else pool_block8<16>(P, ACAT, t0, c8); }
    }
}

__device__ __forceinline__ void s5_scan_item(const float* Z, bf16_t* ASSM, const float* APOW_l, int it, int lane) {
    const int g = it >> 3, b = it & 7, p = lane;
    const float ar = APOW_l[(((size_t)g * 64 + p) * 17 + 16) * 2], ai = APOW_l[(((size_t)g * 64 + p) * 17 + 16) * 2 + 1];
    float sr = 0.f, si = 0.f;
    const size_t row0 = (size_t)g * 1024 + b * 128;
    float zr[16], zi[16], yr[16], yi[16];
#pragma unroll
    for (int c = 0; c < 16; ++c) { const float2 z = *(const float2*)(Z + (row0 + c) * 256 + 2 * p); zr[c] = z.x; zi[c] = z.y; }
    for (int c0 = 0; c0 < 128; c0 += 16) {
        if (c0 + 16 < 128) {
#pragma unroll
            for (int c = 0; c < 16; ++c) { const float2 z = *(const float2*)(Z + (row0 + c0 + 16 + c) * 256 + 2 * p); yr[c] = z.x; yi[c] = z.y; } }
#pragma unroll
        for (int c = 0; c < 16; ++c) {
            *(unsigned*)(ASSM + (row0 + c0 + c) * 384 + 256 + 2 * p) = cvt_pk_bf16(sr, si);
            const float nr = ar * sr - ai * si + zr[c], ni = ar * si + ai * sr + zi[c]; sr = nr; si = ni; }
#pragma unroll
        for (int c = 0; c < 16; ++c) { zr[c] = yr[c]; zi[c] = yi[c]; }
    }
}

__device__ __forceinline__ void sb_attn_unit(const bf16_t* P, const bf16_t* VT, bf16_t* ACAT, int b, int hd, int qb, int lane) {
    const int r32 = lane & 31, hi = lane >> 5;
    const size_t rowbase = (size_t)b * L_;
    const bf16_t* qp = P + (rowbase + 32 * qb + r32) * NIN + 1280 + hd * 64 + 8 * hi;
    bf16x8 qf[4];
#pragma unroll
    for (int d0 = 0; d0 < 4; ++d0) qf[d0] = *(const bf16x8*)(qp + 16 * d0);
    f32x16 o0, o1;
#pragma unroll
    for (int i = 0; i < 16; ++i) { o0[i] = 0.f; o1[i] = 0.f; }
    float R = 1.f;
    for (int kt = qb; kt >= 0; --kt) {
        const bf16_t* kp = P + (rowbase + 32 * kt + r32) * NIN + 1536 + hd * 64 + 8 * hi;
        bf16x8 kf[4];
#pragma unroll
        for (int d0 = 0; d0 < 4; ++d0) kf[d0] = *(const bf16x8*)(kp + 16 * d0);
        const bf16_t* vp = VT + (size_t)(hd * 64 + r32) * T_ + rowbase + 32 * kt + 4 * hi;
        s16x4 va[2][2][2];
#pragma unroll
        for (int db = 0; db < 2; ++db)
#pragma unroll
            for (int s2 = 0; s2 < 2; ++s2) { va[db][s2][0] = *(const s16x4*)(vp + (size_t)db * 32 * T_ + 16 * s2); va[db][s2][1] = *(const s16x4*)(vp + (size_t)db * 32 * T_ + 16 * s2 + 8); }
        f32x16 s;
#pragma unroll
        for (int i = 0; i < 16; ++i) s[i] = 0.f;
#pragma unroll
        for (int d0 = 0; d0 < 4; ++d0) s = __builtin_amdgcn_mfma_f32_32x32x16_bf16(kf[d0], qf[d0], s, 0, 0, 0);
        float sg[16], kq[16];
        const bool diag = (kt == qb);
#pragma unroll
        for (int i = 0; i < 16; ++i) {
            const float z = s[i];
            const float e = __expf(-fmaxf(z, -80.f));
            const float r = __builtin_amdgcn_rcpf(1.0f + e);
            const bool valid = !diag || ((8 * (i >> 2) + 4 * hi + (i & 3)) < r32);
            sg[i] = valid ? r : 0.f;
            kq[i] = valid ? e * r : 1.f;
        }
        float G[4], Gp[4];
#pragma unroll
        for (int g = 0; g < 4; ++g) { G[g] = (kq[4 * g] * kq[4 * g + 1]) * (kq[4 * g + 2] * kq[4 * g + 3]); Gp[g] = shfl_xor_(G[g], 32, lane); }
        float run = R; float aft[4];
#pragma unroll
        for (int g = 3; g >= 0; --g) { aft[g] = hi == 0 ? run * Gp[g] : run; run *= G[g] * Gp[g]; }
        float pa[16];
#pragma unroll
        for (int g = 0; g < 4; ++g) { float sfx = aft[g];
#pragma unroll
            for (int j = 3; j >= 0; --j) { pa[4 * g + j] = sg[4 * g + j] * sfx; sfx *= kq[4 * g + j]; } }
        R = run;
        bf16x8 pf[2];
#pragma unroll
        for (int s2 = 0; s2 < 2; ++s2) { u32x4 w; w.x = cvt_pk_bf16(pa[8 * s2], pa[8 * s2 + 1]); w.y = cvt_pk_bf16(pa[8 * s2 + 2], pa[8 * s2 + 3]); w.z = cvt_pk_bf16(pa[8 * s2 + 4], pa[8 * s2 + 5]); w.w = cvt_pk_bf16(pa[8 * s2 + 6], pa[8 * s2 + 7]);
            pf[s2] = __builtin_bit_cast(bf16x8, w); }
#pragma unroll
        for (int s2 = 0; s2 < 2; ++s2) {
            const bf16x8 v0 = (bf16x8){va[0][s2][0][0], va[0][s2][0][1], va[0][s2][0][2], va[0][s2][0][3], va[0][s2][1][0], va[0][s2][1][1], va[0][s2][1][2], va[0][s2][1][3]};
            const bf16x8 v1 = (bf16x8){va[1][s2][0][0], va[1][s2][0][1], va[1][s2][0][2], va[1][s2][0][3], va[1][s2][1][0], va[1][s2][1][1], va[1][s2][1][2], va[1][s2][1][3]};
            o0 = __builtin_amdgcn_mfma_f32_32x32x16_bf16(v0, pf[s2], o0, 0, 0, 0);
            o1 = __builtin_amdgcn_mfma_f32_32x32x16_bf16(v1, pf[s2], o1, 0, 0, 0);
        }
#if SB_EARLY_EXIT
        if (__all(R < 1.0e-37f)) break;
#endif
    }
    bf16_t* op = ACAT + (rowbase + 32 * qb + r32) * D_ + 768 + hd * 64 + 4 * hi;
#pragma unroll
    for (int g = 0; g < 4; ++g) {
        u32x2 w0; w0.x = cvt_pk_bf16(o0[4 * g], o0[4 * g + 1]); w0.y = cvt_pk_bf16(o0[4 * g + 2], o0[4 * g + 3]);
        u32x2 w1; w1.x = cvt_pk_bf16(o1[4 * g], o1[4 * g + 1]); w1.y = cvt_pk_bf16(o1[4 * g + 2], o1[4 * g + 3]);
        *(u32x2*)(op + 8 * g) = w0; *(u32x2*)(op + 32 + 8 * g) = w1; }
}


__device__ __forceinline__ bool bm_next(const pg8::GOrder& S, int i, int& pm, int& pnh, int& sel) {
    const int ii = i / 10, rem = i - 10 * ii, hh = rem / 5; sel = rem - 5 * hh;
    pg8::Unit u; if (!S.next(ii, u)) return false;
    pm = u.pm; pnh = 2 * u.pn + hh; return true;
}
__device__ __forceinline__ void branch_merge_phase(LAS unsigned char* lds, unsigned char* ws, const unsigned char* wl, int G, int bid, const int tid) {
    using namespace pg8;
    const int wid = __builtin_amdgcn_readfirstlane(tid >> 6), lane = tid & 63, wr = wid >> 2, wc = wid & 3, fr = lane & 15, fq = lane >> 4;
    constexpr int lda = D_, ldb = 256;
    unsigned voffA[2], voffB[2];
#pragma unroll
    for (int i = 0; i < 2; ++i) { int R, C; stage_rc(tid * 16 + i * 8192, R, C); const int Rb = (R & ~31) + perm32(R & 31);
        voffA[i] = (unsigned)(R * lda + C) * 2u; voffB[i] = (unsigned)(Rb * ldb + C) * 2u; }
    const size_t kstep = (size_t)(BK * 2), hsA = (size_t)HALF * lda * 2;
    const unsigned ldsw = (unsigned)wid * 1024u;
    const int aoff = lds_byte(wr * 64 + fr, fq * 8), boff = lds_byte(wc * 32 + fr, fq * 8);
#define BM_SA(b, h) (((b) * 2 + (h)) * HTB)
#define BM_SB(b) ((4 + (b) * 2) * HTB)
#define BM_STAGE(bufoff, gbase, voff) do { _Pragma("unroll") for (int _i = 0; _i < 2; ++_i) \
        __builtin_amdgcn_global_load_lds((const unsigned*)((const char*)(gbase) + (voff)[_i]), (LAS unsigned*)(lds + (bufoff) + ldsw + _i * 8192), 16, 0, 0); } while (0)
#define BM_LDA(dst, b, h) do { _Pragma("unroll") for (int m = 0; m < 4; ++m) _Pragma("unroll") for (int k = 0; k < 2; ++k) dst[m][k] = *(const LAS bf16x8*)(lds + BM_SA(b, h) + aoff + m * 2048 + k * 1024); } while (0)
#define BM_LDB(dst, b) do { _Pragma("unroll") for (int n = 0; n < 2; ++n) _Pragma("unroll") for (int k = 0; k < 2; ++k) dst[n][k] = *(const LAS bf16x8*)(lds + BM_SB(b) + boff + n * 2048 + k * 1024); } while (0)
#define BM_MMA(ai, At, Bt) do { __builtin_amdgcn_s_setprio(1); _Pragma("unroll") for (int m = 0; m < 4; ++m) _Pragma("unroll") for (int n = 0; n < 2; ++n) _Pragma("unroll") for (int k = 0; k < 2; ++k) \
        acc[ai][m][n] = __builtin_amdgcn_mfma_f32_16x16x32_bf16(Bt[n][k], At[m][k], acc[ai][m][n], 0, 0, 0); __builtin_amdgcn_s_setprio(0); } while (0)
#define BM_WAIT_V(n) asm volatile("s_waitcnt vmcnt(" #n ")" ::: "memory")
#define BM_WAIT_L(n) asm volatile("s_waitcnt lgkmcnt(" #n ")" ::: "memory")
#define BM_BAR __builtin_amdgcn_s_barrier()
#define BM_SCHED __builtin_amdgcn_sched_barrier(0)
#define BM_PTRS(pm_, pnh_, sel_, pa_, pb_) do { \
        pa_ = (const char*)(ws + WS_ACAT) + ((size_t)(pm_) * 256 * lda + ((sel_) == 0 ? 0 : ((sel_) == 1 ? 512 : ((sel_) == 2 ? 768 : 256)))) * 2; \
        pb_ = (const char*)wl + ((sel_) == 0 ? OFF_WCONV : ((sel_) == 1 ? OFF_WPOOL : ((sel_) == 2 ? OFF_WSB : OFF_WGLU))) \
              + (size_t)((sel_) < 3 ? (pnh_) * 128 : (pnh_) * 256 + ((sel_) == 4 ? 128 : 0)) * ldb * 2; } while (0)
    GOrder S; S.init(T_, D_, G, bid);
    int ui = 0, pm, pnh, sel, npm, npnh, nsel;
    if (!bm_next(S, 0, pm, pnh, sel)) return;
    f32x4 acc[2][4][2], macc[2][4][2]; u32x2 tmpb[2][4][2];
#pragma unroll
    for (int a = 0; a < 2; ++a)
#pragma unroll
        for (int m = 0; m < 4; ++m)
#pragma unroll
            for (int n = 0; n < 2; ++n) { acc[a][m][n] = (f32x4){0.f, 0.f, 0.f, 0.f}; macc[a][m][n] = (f32x4){0.f, 0.f, 0.f, 0.f}; tmpb[a][m][n] = (u32x2){0u, 0u}; }
    bf16x8 At[4][2], B0[2][2];
    const char* cA; const char* cB; BM_PTRS(pm, pnh, sel, cA, cB);
    BM_STAGE(BM_SB(0), cB, voffB); BM_STAGE(BM_SA(0, 0), cA, voffA); BM_STAGE(BM_SA(0, 1), cA + hsA, voffA);
    if (wr == 1) BM_BAR;
    BM_WAIT_V(2); BM_BAR;
    BM_STAGE(BM_SB(1), cB + kstep, voffB); BM_STAGE(BM_SA(1, 0), cA + kstep, voffA);
    BM_WAIT_V(4); BM_BAR;
    const bf16_t* Pg = (const bf16_t*)(ws + WS_P); bf16_t* Hm = (bf16_t*)(ws + WS_H);
    for (;;) {
        const bool has_next = bm_next(S, ui + 1, npm, npnh, nsel);
        const char* nA = cA; const char* nB = cB; if (has_next) BM_PTRS(npm, npnh, nsel, nA, nB);
#pragma unroll 1
        for (int t = 0; t < 4; t += 2) {
            const bool last = (t == 2);
            const char* a1 = cA + (size_t)(t + 1) * kstep;
            const char* a2 = last ? nA : cA + (size_t)(t + 2) * kstep; const char* b2 = last ? nB : cB + (size_t)(t + 2) * kstep;
            const char* a3 = a2 + kstep; const char* b3 = b2 + kstep;
            BM_LDB(B0, 0); BM_SCHED; BM_LDA(At, 0, 0); BM_STAGE(BM_SA(1, 1), a1 + hsA, voffA);
            BM_WAIT_V(6); BM_WAIT_L(0); BM_BAR; BM_MMA(0, At, B0); BM_BAR; BM_SCHED;
            BM_LDA(At, 0, 1); BM_STAGE(BM_SB(0), b2, voffB); BM_STAGE(BM_SA(0, 0), a2, voffA);
            BM_WAIT_V(6); BM_WAIT_L(0); BM_BAR; BM_MMA(1, At, B0); BM_BAR; BM_SCHED;
            BM_LDB(B0, 1); BM_SCHED; BM_LDA(At, 1, 0); BM_STAGE(BM_SA(0, 1), a2 + hsA, voffA);
            BM_WAIT_V(6); BM_WAIT_L(0); BM_BAR; BM_MMA(0, At, B0); BM_BAR; BM_SCHED;
            BM_LDA(At, 1, 1); BM_STAGE(BM_SB(1), b3, voffB); BM_STAGE(BM_SA(1, 0), a3, voffA);
            BM_WAIT_V(6); BM_WAIT_L(0); BM_BAR; BM_MMA(1, At, B0); BM_BAR; BM_SCHED;
        }
        if (wr == 0) BM_BAR;
        {
            const int row0 = pm * 256 + wr * 64 + fr, col = pnh * 128 + wc * 32 + 8 * fq;
            const int gcol = sel == 0 ? 2048 : (sel == 1 ? 4096 : (sel == 2 ? 5120 : 3072));
#pragma unroll
            for (int ai = 0; ai < 2; ++ai)
#pragma unroll
                for (int m = 0; m < 4; ++m) { const int r = row0 + ai * HALF + m * 16;
                    if (sel == 3) {
#pragma unroll
                        for (int n = 0; n < 2; ++n) { tmpb[ai][m][n].x = cvt_pk_bf16(acc[ai][m][n][0], acc[ai][m][n][1]); tmpb[ai][m][n].y = cvt_pk_bf16(acc[ai][m][n][2], acc[ai][m][n][3]); }
                    } else {
                        float gt[8]; unpack8(*(const u32x4*)(Pg + (size_t)r * NIN + gcol + col), gt);
#pragma unroll
                        for (int q = 0; q < 8; ++q) gt[q] = sigmoidf_(gt[q]);
#pragma unroll
                        for (int n = 0; n < 2; ++n)
#pragma unroll
                            for (int i = 0; i < 4; ++i) {
                                float y = acc[ai][m][n][i];
                                if (sel == 4) { const unsigned tw = i < 2 ? tmpb[ai][m][n].x : tmpb[ai][m][n].y; y = ((i & 1) ? bf_hi(tw) : bf_lo(tw)) * sigmoidf_(y); }
                                const float v = gt[4 * n + i] * y;
                                macc[ai][m][n][i] = sel == 0 ? v : macc[ai][m][n][i] + v; }
                        if (sel == 4) { float v[8];
#pragma unroll
                            for (int n = 0; n < 2; ++n)
#pragma unroll
                                for (int i = 0; i < 4; ++i) v[4 * n + i] = macc[ai][m][n][i];
                            *(u32x4*)(Hm + (size_t)r * D_ + col) = pack8(v); }
                    } }
        }
        if (!has_next) break;
#pragma unroll
        for (int a = 0; a < 2; ++a)
#pragma unroll
            for (int m = 0; m < 4; ++m)
#pragma unroll
                for (int n = 0; n < 2; ++n) acc[a][m][n] = (f32x4){0.f, 0.f, 0.f, 0.f};
        pm = npm; pnh = npnh; sel = nsel; cA = nA; cB = nB; ++ui;
        if (wr == 1) BM_BAR;
    }
    BM_WAIT_V(0);
    BM_BAR;
#undef BM_SA
#undef BM_SB
#undef BM_STAGE
#undef BM_LDA
#undef BM_LDB
#undef BM_MMA
#undef BM_WAIT_V
#undef BM_WAIT_L
#undef BM_BAR
#undef BM_SCHED
#undef BM_PTRS
}

__global__ void __launch_bounds__(512, 2) mega(Args args) {
    extern __shared__ __attribute__((aligned(16))) unsigned char smem[];
    LAS unsigned char* lds = (LAS unsigned char*)smem;
    const int G = gridDim.x; int bid = blockIdx.x;
    const int ngw = G * 8, ngt = G * 512;
    LAS unsigned long long* tab = (LAS unsigned long long*)(lds + 131072);
    volatile LAS unsigned* bst = (volatile LAS unsigned*)(lds + 131072 + 512);
    if (threadIdx.x == 0) { bst[0] = 0u; bst[1] = 0u; }
    __syncthreads();
    (void)xcd_barrier_post((unsigned*)(args.ws + WS_BAR), bst);
    if (threadIdx.x == 0) { const unsigned xcc = xb_xcc_id(); bst[2] = xcc; bst[3] = xb_add((unsigned*)(args.ws + WS_BAR) + XCD_BAR_WORDS + 64 * (xcc & 7u), 1u); }
    if (threadIdx.x == 0) {
#pragma unroll
        for (int i = 0; i < 25; ++i) tab[i] = (unsigned long long)args.in[i];
    }
    __syncthreads();
    Ctx a; a.tab = tab; a.ws = (unsigned char*)(GAS unsigned char*)(unsigned long long)args.ws;
    for (int ph = args.ph_lo; ph < args.ph_hi; ++ph) {
        if (args.coop && ph == args.ph_lo + 1) {
            if (threadIdx.x == 0) { unsigned* bar = (unsigned*)(args.ws + WS_BAR); bool ok = (G % 8) == 0;
                for (unsigned j = 0; j < 16; ++j) { const unsigned c = xb_ld(&bar[XB_XCNT(j)]); ok = ok && (c == (j < 8 ? (unsigned)(G / 8) : 0u)); }
                const unsigned cv = bst[3] * 8u + bst[2]; bst[4] = (ok && cv < (unsigned)G) ? cv : (unsigned)blockIdx.x; }
            __syncthreads();
            bid = (int)__builtin_amdgcn_readfirstlane(bst[4]);
        }
#define LOCAL_IDS() int tid = threadIdx.x; asm volatile("" : "+v"(tid)); const int lane = tid & 63, wave = __builtin_amdgcn_readfirstlane(tid >> 6); \
        const int gw = bid * 8 + wave, gt = bid * 512 + tid; (void)lane; (void)gw; (void)gt;
        unsigned long long wsi = (unsigned long long)args.ws; asm volatile("" : "+s"(wsi));
        unsigned char* ws = (unsigned char*)(GAS unsigned char*)wsi;
        float* X = args.out;
        float* ADA = (float*)(ws + WS_ADA);
        bf16_t* H = (bf16_t*)(ws + WS_H); bf16_t* P = (bf16_t*)(ws + WS_P); float* F = (float*)(ws + WS_F);
        bf16_t* ACAT = (bf16_t*)(ws + WS_ACAT); bf16_t* ASSM = (bf16_t*)(ws + WS_ASSM); float* Z = (float*)(ws + WS_Z); bf16_t* VT = (bf16_t*)(ws + WS_VT);
        if (ph >= 1000) {
            LOCAL_IDS();
            for (size_t i = gt; i < (size_t)T_ * D_; i += ngt) { float v = 0.f;
                if (ph == 1000) { v = bf_lo(ACAT[i]); if (!((MK_DUMP_MASK >> ((i & 1023) >> 8)) & 1)) v = 0.f; }
                else if (ph == 1001) v = F[i];
                else if (ph == 1002) v = bf_lo(H[i]);
                else if (ph == 1003) v = i < (size_t)256 * T_ ? bf_lo(VT[i]) : 0.f;
                else if (ph == 1004) { const size_t t = i >> 10, c = i & 1023; v = c < 512 ? bf_lo(P[t * NIN + 1280 + c]) : 0.f; }
                X[i] = v; }
        } else if (ph == 0) {
            LOCAL_IDS();
            p0_ada(a, (LAS float*)lds, tid, lane, wave, bid, G);
            p0_tables(a, gt, ngt);
            LAS float* scr = (LAS float*)(lds + wave * 16384);
            for (int it = gw; it < DEPTH * IT_POOL; it += ngw) p0_pool_item(a, it, lane);
            p0_transposes(a, gw, ngw, scr, lane);
        } else if (ph == 1) {
            LOCAL_IDS();
            if (T_ == 8 * ngw) rowop_c(a.in(0), nullptr, nullptr, (bf16_t*)(ws + WS_XB), nullptr, 0.f, nullptr, nullptr, true, ADA, a.in(4), H, gw, lane);
            else rowop(a.in(0), nullptr, nullptr, (bf16_t*)(ws + WS_XB), nullptr, 0.f, nullptr, nullptr, true, ADA, a.in(4), H, gw, ngw, lane);
            p1_kern(a, gt, ngt);
        } else {
            const int l = (ph - 2) / 11, st = (ph - 2) % 11;
            unsigned char* wl = ws + WS_W + (size_t)l * LAYER_W;
            const float* ada_l = ADA + (size_t)l * 8 * 9216;
            if (ph == 2) { LOCAL_IDS(); p2_fill(a, gt, ngt); }
            if (st == 2 || st == 7 || st == 10) {
                LOCAL_IDS();
                const int sub = st == 2 ? 0 : (st == 7 ? 1 : 2);
                const float resw = sub == 1 ? 1.0f : 0.5f;
                const bool last = (st == 10 && l == DEPTH - 1);
                const int nl = st == 10 ? l + 1 : l, nsub = st == 10 ? 0 : sub + 1;
                const float* ada_n = ADA + (size_t)(last ? l : nl) * 8 * 9216 + nsub * 3072;
                const float* gpre = a.in(4) + (size_t)((last ? l : nl) * 3 + nsub) * D_;
                if (T_ == 8 * ngw)
                    rowop_c(nullptr, (const bf16_t*)(ws + WS_XB), last ? X : nullptr, (bf16_t*)(ws + WS_XB), (const bf16_t*)F, resw, ada_l + sub * 3072 + 2048, a.in(5) + (size_t)(l * 3 + sub) * D_, !last, ada_n, gpre, H, gw, lane);
                else
                    rowop(nullptr, (const bf16_t*)(ws + WS_XB), last ? X : nullptr, (bf16_t*)(ws + WS_XB), (const bf16_t*)F, resw, ada_l + sub * 3072 + 2048, a.in(5) + (size_t)(l * 3 + sub) * D_, !last, ada_n, gpre, H, gw, ngw, lane);
            } else {
                if (st == 5) { int tidg = threadIdx.x; asm volatile("" : "+v"(tidg)); branch_merge_phase(lds, ws, wl, G, bid, tidg); }
                const int ng = st == 5 ? 0 : ((st == 3 || st == 4) ? 2 : 1);
                for (int gi = 0; gi < ng; ++gi) {
                    pg8::Gemm g; pg8::GOrder S; pg8::GEpi E;
                    g.bshift = 0; g.bgs = 0;
                    E.mode_ = pg8::EM_FB16; E.gcol_ = 0; E.ws = ws; E.dskip = nullptr;
                    if (st == 0 || st == 8) {
                        g.A = H; g.Bt = (const bf16_t*)(wl + OFF_FFIN0 + (st == 8 ? SZ_FFIN : 0)); g.K = D_; g.lda = D_; g.ldb = D_;
                        S.init(T_, 2 * FF_, G, bid); E.mode_ = pg8::EM_SWIGLU;
                    } else if (st == 1 || st == 9) {
                        g.A = P; g.Bt = (const bf16_t*)(wl + OFF_FFOUT0 + (st == 9 ? SZ_FFOUT : 0)); g.K = FF_; g.lda = FF_; g.ldb = FF_;
                        S.init(T_, D_, G, bid);
                    } else if (st == 3 && gi == 0) {
                        g.A = H; g.Bt = (const bf16_t*)(wl + OFF_WIN); g.K = D_; g.lda = D_; g.ldb = D_;
                        S.init(T_, NIN - 256, G, bid); S.skip = 7; E.mode_ = pg8::EM_MIXIN;
                    } else if (st == 3) {
                        g.A = (const bf16_t*)(wl + OFF_WIN) + (size_t)7 * 256 * D_; g.Bt = H; g.K = D_; g.lda = D_; g.ldb = D_;
                        const int rem = (64 * 23) % G;
                        S.init(256, T_, G, (bid - rem + G) % G); E.mode_ = pg8::EM_BF16;
                    } else if (st == 4 && gi == 0) {
                        g.A = ASSM; g.Bt = (const bf16_t*)(wl + OFF_WZ); g.K = 256; g.lda = 384; g.ldb = 256; g.bshift = 2; g.bgs = (size_t)256 * 256;
                        S.init(16384, 256, G, bid); E.mode_ = pg8::EM_F32Z;
                    } else if (st == 4) {
                        g.A = ASSM; g.Bt = (const bf16_t*)(wl + OFF_TM); g.K = 384; g.lda = 384; g.ldb = 384; g.bshift = 2; g.bgs = (size_t)256 * 384;
                        S.init(16384, 256, G, bid); E.mode_ = pg8::EM_S5Y; E.dskip = a.in(18) + (size_t)l * 256;
                    } else if (st == 5) {
                        g.A = ACAT; g.Bt = (const bf16_t*)(wl + OFF_WCONV); g.K = 256; g.lda = D_; g.ldb = 256;
                        S.init(T_, D_, G, bid); S.branch = 1; E.mode_ = pg8::EM_BRANCH;
                    } else {
                        g.A = H; g.Bt = (const bf16_t*)(wl + OFF_WOUT); g.K = D_; g.lda = D_; g.ldb = D_;
                        S.init(T_, D_, G, bid);
                    }
                    { int tidg = threadIdx.x; asm volatile("" : "+v"(tidg)); pg8::gemm_phase<pg8::GEpi, pg8::GOrder, true>(lds, g, S, E, tidg); }
                    if (st == 4 && gi == 0) {
                        LOCAL_IDS();
                        const float* APOW_l = (const float*)(ws + WS_APOW) + (size_t)l * 16 * 64 * 17 * 2;
                        pg8::Unit u;
                        for (int i = 0; S.next(i, u); ++i) { const int it = (u.pm >> 2) * 8 + 2 * (u.pm & 3) + ((wave + 2 * i) & 1); if (((wave + 2 * i) & 7) < 2) s5_scan_item(Z, ASSM, APOW_l, it, lane); }
                        asm volatile("s_waitcnt vmcnt(0)" ::: "memory");
                        __syncthreads();
                    }
                }
                if (st == 4) {
                    LOCAL_IDS();
                    const int afirst = G > 64 ? 64 : 0, nslots = (G - afirst) * 8;
                    if (bid >= afirst) convpool(P, ACAT, a.in(9) + (size_t)l * 3 * 256, (bid - afirst) * 512 + tid, (G - afirst) * 512);
                    if (bid >= afirst)
                        for (int u = (bid - afirst) * 8 + wave; u < NB * 4 * 64; u += nslots) { const int qb = 63 - (u & 63), bh = u >> 6; sb_attn_unit(P, VT, ACAT, bh >> 2, bh & 3, qb, lane); }
                }
            }
        }
        if (ph + 1 < args.ph_hi && args.coop) {
            if (args.coop < 0) cg::this_grid().sync();
            { XcdBarrier xb; xb.bar = (unsigned*)(args.ws + WS_BAR); xb.x = xb_xcc_id(); xb.st = bst; xcd_barrier(xb); }
        }
    }
}

extern "C" void kernel_launch(void* const* d_in, const int* in_sizes, int n_in, void* d_out, int out_size, void* d_ws, size_t ws_size, hipStream_t stream) {
    static int grid = 0;
    if (grid == 0) {
        if (n_in != 25 || out_size != T_ * D_ || ws_size < WS_END) { fprintf(stderr, "kernel_launch: unexpected shapes: n_in %d out %d ws %zu (need %zu)\n", n_in, out_size, ws_size, (size_t)WS_END); grid = -1; return; }
        int dev = 0, cus = 0, per_cu = 0;
        (void)hipGetDevice(&dev);
        (void)hipDeviceGetAttribute(&cus, hipDeviceAttributeMultiprocessorCount, dev);
        if (hipFuncSetAttribute((const void*)mega, hipFuncAttributeMaxDynamicSharedMemorySize, LDS_BYTES) != hipSuccess) { fprintf(stderr, "kernel_launch: hipFuncSetAttribute failed\n"); grid = -1; return; }
        (void)hipOccupancyMaxActiveBlocksPerMultiprocessor(&per_cu, (const void*)mega, 512, LDS_BYTES);
        if (per_cu < 1) { fprintf(stderr, "kernel_launch: occupancy query says %d blocks per CU\n", per_cu); per_cu = 1; }
        (void)hipGetLastError();
        grid = cus * per_cu;
        if (grid > 256) grid = 256;
        fprintf(stderr, "kernel_launch: grid %d (cus %d, per_cu %d), ws need %zu MiB of %zu MiB\n", grid, cus, per_cu, (size_t)(WS_END >> 20), ws_size >> 20);
    }
    if (grid < 0) return;
    Args a{};
    for (int i = 0; i < 25; ++i) a.in[i] = (const float*)d_in[i];
    a.out = (float*)d_out; a.ws = (unsigned char*)d_ws;
#if MK_PER_PHASE
    for (int ph = 0; ph < NPHASE; ++ph) { a.ph_lo = ph; a.ph_hi = ph + 1; a.coop = 0; hipLaunchKernelGGL(mega, dim3(grid), dim3(512), LDS_BYTES, stream, a); }
#ifdef MK_DUMP
    a.ph_lo = MK_DUMP; a.ph_hi = MK_DUMP + 1; a.coop = 0; hipLaunchKernelGGL(mega, dim3(grid), dim3(512), LDS_BYTES, stream, a);
#endif
#else
    (void)hipMemsetAsync((char*)d_ws + WS_BAR, 0, BAR_BYTES, stream);
    a.ph_lo = 0; a.ph_hi = NPHASE; a.coop = 1;
    void* args[] = {&a};
    hipError_t e = hipLaunchCooperativeKernel((const void*)mega, dim3(grid), dim3(512), args, LDS_BYTES, stream);
    if (e != hipSuccess) fprintf(stderr, "kernel_launch: cooperative launch failed: %s (grid %d)\n", hipGetErrorString(e), grid);
#endif
}
```
